# Optimizing an MI355X kernel written in HIP

```python
import jax, jax.numpy as jnp
from jax import lax
import numpy as np

D_MODEL = 1024
BATCH = 8
SEQ = 4096
DEPTH = 2
DEC_BATCH = 2
DEC_SEQ = 8192
PAST_LEN = 128

N_META = 16
GRID_W = 64
D_FF = 2816
EPS = 1e-6
Q_BLOCK = 128
NEG_INF = -1e30
MLA_HEADS = 8
MLA_Q_LORA = 256
MLA_KV_LORA = 128
MLA_NOPE = 64
MLA_ROPE = 32
MLA_V = 64
MLA_THETA = 10000.0
GQA_HEADS = 8
GQA_KV_HEADS = 2
GQA_HEAD_DIM = 64
AXIAL_THETA = 10000.0
NA_HEADS = 16
NA_HEAD_DIM = D_MODEL // NA_HEADS
NA_WIN_R = 8
NA_WIN_C = 16
N_EVEN = (DEPTH + 1) // 2
N_ODD = DEPTH // 2
IN_SPLITS = (MLA_Q_LORA, MLA_KV_LORA, MLA_ROPE, GQA_HEADS * GQA_HEAD_DIM,
             GQA_KV_HEADS * GQA_HEAD_DIM, GQA_KV_HEADS * GQA_HEAD_DIM)
IN_COLS = sum(IN_SPLITS)
MIX_WIDTH = MLA_HEADS * MLA_V + GQA_HEADS * GQA_HEAD_DIM

kernel_name = "hybrid_mla_gqa_natten_macaron_encoder"


def rmsnorm(x, g):
    x32 = x.astype(jnp.float32)
    y = x32 * lax.rsqrt(jnp.mean(x32 * x32, axis=-1, keepdims=True) + EPS)
    return (y * g.astype(jnp.float32)).astype(x.dtype)


def swiglu(x, wg, wu, wd):
    return (jax.nn.silu(x @ wg) * (x @ wu)) @ wd


def rope(x, pos, theta):
    half = x.shape[-1] // 2
    inv = 1.0 / (theta ** (jnp.arange(half, dtype=jnp.float32) / half))
    ang = pos.astype(jnp.float32)[:, None] * inv[None, :]
    cos = jnp.cos(ang)[:, None, :]
    sin = jnp.sin(ang)[:, None, :]
    x32 = x.astype(jnp.float32)
    x1, x2 = x32[..., :half], x32[..., half:]
    return jnp.concatenate([x1 * cos - x2 * sin, x2 * cos + x1 * sin], axis=-1).astype(x.dtype)


def blocked_attention(q, k, v, scale):
    b, L, hk, g, dk = q.shape
    nb = -(-L // Q_BLOCK)
    lp = nb * Q_BLOCK
    qp = jnp.pad(q, ((0, 0), (0, lp - L), (0, 0), (0, 0), (0, 0)))
    qb = jnp.moveaxis(qp.reshape(b, nb, Q_BLOCK, hk, g, dk), 1, 0)

    def one_block(qi):
        s = jnp.einsum('bqhgd,bkhd->bhgqk', qi, k).astype(jnp.float32) * scale
        p = jax.nn.softmax(s, axis=-1).astype(v.dtype)
        return jnp.einsum('bhgqk,bkhe->bqhge', p, v)

    o = lax.map(one_block, qb)
    return jnp.moveaxis(o, 0, 1).reshape(b, lp, hk, g, v.shape[-1])[:, :L]


def mla_gqa_mixer(h, w_in, q_norm, w_uq, kv_norm, w_ukv, gq_norm, gk_norm, w_out):
    b, L, _ = h.shape
    n_tok = L - N_META
    proj = h @ w_in
    cuts = np.cumsum(IN_SPLITS)[:-1].tolist()
    cq, ckv, kr, qb_, kb_, vb_ = jnp.split(proj, cuts, axis=-1)
    pos = jnp.arange(L, dtype=jnp.float32)
    qa = (rmsnorm(cq, q_norm) @ w_uq).reshape(b, L, MLA_HEADS, MLA_NOPE + MLA_ROPE)
    qa = jnp.concatenate([qa[..., :MLA_NOPE], rope(qa[..., MLA_NOPE:], pos, MLA_THETA)], axis=-1)
    kv = (rmsnorm(ckv, kv_norm) @ w_ukv).reshape(b, L, MLA_HEADS, MLA_NOPE + MLA_V)
    k_rope = jnp.broadcast_to(rope(kr[:, :, None, :], pos, MLA_THETA), (b, L, MLA_HEADS, MLA_ROPE))
    ka = jnp.concatenate([kv[..., :MLA_NOPE], k_rope], axis=-1)
    o_a = blocked_attention(qa[:, :, :, None, :], ka, kv[..., MLA_NOPE:],
                            (MLA_NOPE + MLA_ROPE) ** -0.5)
    tok = jnp.arange(n_tok)
    row = jnp.concatenate([jnp.full((N_META,), -1.0, jnp.float32), (tok // GRID_W).astype(jnp.float32)])
    col = jnp.concatenate([jnp.arange(N_META, dtype=jnp.float32), (tok % GRID_W).astype(jnp.float32)])
    half = GQA_HEAD_DIM // 2

    def axial(x):
        return jnp.concatenate([rope(x[..., :half], row, AXIAL_THETA),
                                rope(x[..., half:], col, AXIAL_THETA)], axis=-1)

    qg = axial(rmsnorm(qb_.reshape(b, L, GQA_HEADS, GQA_HEAD_DIM), gq_norm))
    qg = qg.reshape(b, L, GQA_KV_HEADS, GQA_HEADS // GQA_KV_HEADS, GQA_HEAD_DIM)
    kg = axial(rmsnorm(kb_.reshape(b, L, GQA_KV_HEADS, GQA_HEAD_DIM), gk_norm))
    vg = vb_.reshape(b, L, GQA_KV_HEADS, GQA_HEAD_DIM)
    o_b = blocked_attention(qg, kg, vg, GQA_HEAD_DIM ** -0.5)
    o = jnp.concatenate([o_a.reshape(b, L, -1), o_b.reshape(b, L, -1)], axis=-1)
    return o @ w_out


def neighbourhood_mixer(h, w_qkv, rpb, meta_bias, w_out):
    b, L, _ = h.shape
    n_tok = L - N_META
    rows = n_tok // GRID_W
    win_r = min(NA_WIN_R, rows)
    kblk_len = win_r * GRID_W
    qkv = (h @ w_qkv).reshape(b, L, 3, NA_HEADS, NA_HEAD_DIM)
    q = qkv[:, :, 0] * (NA_HEAD_DIM ** -0.5)
    k = qkv[:, :, 1]
    v = qkv[:, :, 2]
    qm, km, vm = q[:, :N_META], k[:, :N_META], v[:, :N_META]
    grid = (b, rows, GRID_W, NA_HEADS, NA_HEAD_DIM)
    qg = q[:, N_META:].reshape(grid)
    kg = k[:, N_META:].reshape(grid)
    vg = v[:, N_META:].reshape(grid)
    r_idx = jnp.arange(rows)
    r_start = jnp.clip(r_idx - win_r // 2, 0, rows - win_r)
    c_idx = jnp.arange(GRID_W)
    c_start = jnp.clip(c_idx - NA_WIN_C // 2, 0, GRID_W - NA_WIN_C)
    col_mask = (c_idx[None, :] >= c_start[:, None]) & (c_idx[None, :] < c_start[:, None] + NA_WIN_C)
    blk_mask = jnp.tile(col_mask, (1, win_r))
    col_off = jnp.clip(c_idx[None, :] - c_idx[:, None] + NA_WIN_C - 1, 0, 2 * NA_WIN_C - 2)
    rpb_c = rpb[:, :, col_off]
    mb = meta_bias[:, None, :].astype(jnp.float32)

    def one_row(args):
        q_r, r = args
        rs = r_start[r]
        k_blk = lax.dynamic_slice_in_dim(kg, rs, win_r, axis=1).reshape(b, kblk_len, NA_HEADS, NA_HEAD_DIM)
        v_blk = lax.dynamic_slice_in_dim(vg, rs, win_r, axis=1).reshape(b, kblk_len, NA_HEADS, NA_HEAD_DIM)
        row_off = rs + jnp.arange(win_r) - r + NA_WIN_R - 1
        bias = jnp.take(rpb_c, row_off, axis=1).transpose(0, 2, 1, 3).reshape(NA_HEADS, GRID_W, kblk_len)
        s_g = jnp.einsum('bqhd,bkhd->bhqk', q_r, k_blk).astype(jnp.float32) + bias.astype(jnp.float32)
        s_g = jnp.where(blk_mask, s_g, NEG_INF)
        s_m = jnp.einsum('bqhd,bmhd->bhqm', q_r, km).astype(jnp.float32) + mb
        p = jax.nn.softmax(jnp.concatenate([s_g, s_m], axis=-1), axis=-1).astype(v.dtype)
        return (jnp.einsum('bhqk,bkhd->bqhd', p[..., :kblk_len], v_blk)
                + jnp.einsum('bhqm,bmhd->bqhd', p[..., kblk_len:], vm))

    o_g = lax.map(one_row, (jnp.moveaxis(qg, 1, 0), r_idx))
    o_g = jnp.moveaxis(o_g, 0, 1).reshape(b, n_tok, NA_HEADS * NA_HEAD_DIM)
    s_mm = jnp.einsum('bqhd,bmhd->bhqm', qm, km).astype(jnp.float32) + mb
    p_mm = jax.nn.softmax(s_mm, axis=-1).astype(v.dtype)
    o_m = jnp.einsum('bhqm,bmhd->bqhd', p_mm, vm).reshape(b, N_META, NA_HEADS * NA_HEAD_DIM)
    return jnp.concatenate([o_m, o_g], axis=1) @ w_out


def encoder(x, meta, norm_gains, ffn1_w_gate, ffn1_w_up, ffn1_w_down, ffn2_w_gate, ffn2_w_up,
            ffn2_w_down, attn_w_in, mla_q_norm, mla_w_uq, mla_kv_norm, mla_w_ukv, gqa_q_norm,
            gqa_k_norm, attn_w_out, na_w_qkv, na_rpb, na_meta_bias, na_w_out):
    b = x.shape[0]
    h = jnp.concatenate([jnp.broadcast_to(meta.astype(x.dtype)[None], (b, N_META, D_MODEL)), x], axis=1)
    for i in range(DEPTH):
        g = norm_gains[i]
        h = h + 0.5 * rmsnorm(swiglu(rmsnorm(h, g[0]), ffn1_w_gate[i], ffn1_w_up[i], ffn1_w_down[i]), g[1])
        a = rmsnorm(h, g[2])
        j = i // 2
        if i % 2 == 0:
            m = mla_gqa_mixer(a, attn_w_in[j], mla_q_norm[j], mla_w_uq[j], mla_kv_norm[j], mla_w_ukv[j],
                              gqa_q_norm[j], gqa_k_norm[j], attn_w_out[j])
        else:
            m = neighbourhood_mixer(a, na_w_qkv[j], na_rpb[j], na_meta_bias[j], na_w_out[j])
        h = h + rmsnorm(m, g[3])
        h = h + 0.5 * rmsnorm(swiglu(rmsnorm(h, g[4]), ffn2_w_gate[i], ffn2_w_up[i], ffn2_w_down[i]), g[5])
    return h[:, N_META:]


def setup_inputs(seed: int = 0) -> dict:
    key = jax.random.key(seed)
    ks = jax.random.split(key, 24)

    def nrm(k, shape, scale):
        return jax.random.normal(k, shape, jnp.float32) * scale

    def gain(k, shape):
        return 1.0 + 0.05 * jax.random.normal(k, shape, jnp.float32)

    D, F = D_MODEL, D_FF
    return {
        "x_prompt": nrm(ks[0], (BATCH, SEQ, D), 1.0),
        "x_sample": nrm(ks[1], (DEC_BATCH, DEC_SEQ, D), 1.0),
        "meta": nrm(ks[2], (N_META, D), 1.0),
        "norm_gains": gain(ks[3], (DEPTH, 6, D)),
        "ffn1_w_gate": nrm(ks[4], (DEPTH, D, F), D ** -0.5),
        "ffn1_w_up": nrm(ks[5], (DEPTH, D, F), D ** -0.5),
        "ffn1_w_down": nrm(ks[6], (DEPTH, F, D), F ** -0.5),
        "ffn2_w_gate": nrm(ks[7], (DEPTH, D, F), D ** -0.5),
        "ffn2_w_up": nrm(ks[8], (DEPTH, D, F), D ** -0.5),
        "ffn2_w_down": nrm(ks[9], (DEPTH, F, D), F ** -0.5),
        "attn_w_in": nrm(ks[10], (N_EVEN, D, IN_COLS), D ** -0.5),
        "mla_q_norm": gain(ks[11], (N_EVEN, MLA_Q_LORA)),
        "mla_w_uq": nrm(ks[12], (N_EVEN, MLA_Q_LORA, MLA_HEADS * (MLA_NOPE + MLA_ROPE)), MLA_Q_LORA ** -0.5),
        "mla_kv_norm": gain(ks[13], (N_EVEN, MLA_KV_LORA)),
        "mla_w_ukv": nrm(ks[14], (N_EVEN, MLA_KV_LORA, MLA_HEADS * (MLA_NOPE + MLA_V)), MLA_KV_LORA ** -0.5),
        "gqa_q_norm": gain(ks[15], (N_EVEN, GQA_HEAD_DIM)),
        "gqa_k_norm": gain(ks[16], (N_EVEN, GQA_HEAD_DIM)),
        "attn_w_out": nrm(ks[17], (N_EVEN, MIX_WIDTH, D), MIX_WIDTH ** -0.5),
        "na_w_qkv": nrm(ks[18], (N_ODD, D, 3 * NA_HEADS * NA_HEAD_DIM), D ** -0.5),
        "na_rpb": nrm(ks[19], (N_ODD, NA_HEADS, 2 * NA_WIN_R - 1, 2 * NA_WIN_C - 1), 0.1),
        "na_meta_bias": nrm(ks[20], (N_ODD, NA_HEADS, N_META), 0.1),
        "na_w_out": nrm(ks[21], (N_ODD, NA_HEADS * NA_HEAD_DIM, D), (NA_HEADS * NA_HEAD_DIM) ** -0.5),
    }


def reference(x_prompt, x_sample, meta, norm_gains, ffn1_w_gate, ffn1_w_up, ffn1_w_down, ffn2_w_gate,
              ffn2_w_up, ffn2_w_down, attn_w_in, mla_q_norm, mla_w_uq, mla_kv_norm, mla_w_ukv,
              gqa_q_norm, gqa_k_norm, attn_w_out, na_w_qkv, na_rpb, na_meta_bias, na_w_out):
    y_prompt = encoder(x_prompt, meta, norm_gains, ffn1_w_gate, ffn1_w_up, ffn1_w_down, ffn2_w_gate,
                       ffn2_w_up, ffn2_w_down, attn_w_in, mla_q_norm, mla_w_uq, mla_kv_norm, mla_w_ukv,
                       gqa_q_norm, gqa_k_norm, attn_w_out, na_w_qkv, na_rpb, na_meta_bias, na_w_out)
    y_sample = encoder(x_sample, meta, norm_gains, ffn1_w_gate, ffn1_w_up, ffn1_w_down, ffn2_w_gate,
                       ffn2_w_up, ffn2_w_down, attn_w_in, mla_q_norm, mla_w_uq, mla_kv_norm, mla_w_ukv,
                       gqa_q_norm, gqa_k_norm, attn_w_out, na_w_qkv, na_rpb, na_meta_bias, na_w_out)
    return (y_prompt, y_sample)
```

```cpp
#include <hip/hip_runtime.h>
#include <hip/hip_cooperative_groups.h>
#include <cstdint>
#include <cstdio>
#include <cmath>
namespace cg = cooperative_groups;

typedef unsigned short bf16_t;
typedef short bf16x8 __attribute__((ext_vector_type(8)));
typedef float f32x4 __attribute__((ext_vector_type(4)));
typedef unsigned u32x4 __attribute__((ext_vector_type(4)));
typedef unsigned u32x2 __attribute__((ext_vector_type(2)));

#define DEVI __device__ __forceinline__
#define LDSP unsigned*

constexpr int MROWS = 49792;
constexpr int MT128 = 389;
constexpr int DM = 1024;
constexpr int DFF = 2816;
constexpr float EPSF = 1e-6f;
constexpr float LOG2E = 1.4426950408889634f;

constexpr size_t WS_CTR = 0;
constexpr size_t WS_BAR = 4096;
constexpr size_t WS_TAB = 4096 + 16384;
constexpr size_t WS_HM  = WS_TAB + 1052672;
constexpr size_t WS_W   = WS_HM + 655360;
constexpr size_t W_FFN_EL = 8650752;
constexpr size_t W_GU_EL = 5767168;
constexpr size_t W_IN_OFF   = 4 * W_FFN_EL;
constexpr size_t W_UQ_OFF   = W_IN_OFF + 1572864;
constexpr size_t W_UKV_OFF  = W_UQ_OFF + 196608;
constexpr size_t W_OUT_OFF  = W_UKV_OFF + 131072;
constexpr size_t W_NAQKV_OFF = W_OUT_OFF + 1048576;
constexpr size_t W_NAOUT_OFF = W_NAQKV_OFF + 3145728;
constexpr size_t W_TOTAL_EL = W_NAOUT_OFF + 1048576;
constexpr size_t WS_A = WS_W + W_TOTAL_EL * 2;
constexpr size_t WS_H = WS_A + (size_t)MROWS * 1024 * 2;
constexpr size_t H_PROJ = 0;
constexpr size_t H_QA   = (size_t)MROWS * 1056;
constexpr size_t H_KMLA = (size_t)MROWS * (1056 + 768);
constexpr size_t H_VTM  = (size_t)MROWS * 2592;
constexpr size_t H_VTG  = (size_t)MROWS * 3104;
constexpr size_t H_END0 = (size_t)MROWS * 3232;
constexpr size_t H_NAQK = 0;
constexpr size_t H_VTN  = (size_t)MROWS * 2048;
constexpr size_t WS_NEED = WS_H + H_END0 * 2;

struct Params {
  const float* x_prompt; const float* x_sample; const float* meta; const float* norm_gains;
  const float* ffn_w[6];
  const float* attn_w_in; const float* mla_q_norm; const float* mla_w_uq; const float* mla_kv_norm; const float* mla_w_ukv;
  const float* gqa_q_norm; const float* gqa_k_norm; const float* attn_w_out;
  const float* na_w_qkv; const float* na_rpb; const float* na_meta_bias; const float* na_w_out;
  float* out; unsigned char* ws;
  float inv_freq[16];
};

DEVI float bf2f(unsigned v) { return __uint_as_float(v << 16); }
DEVI float bflo(unsigned v) { return __uint_as_float(v << 16); }
DEVI float bfhi(unsigned v) { return __uint_as_float(v & 0xffff0000u); }
typedef __bf16 bf16x2_t __attribute__((ext_vector_type(2)));
typedef float f32x2_t __attribute__((ext_vector_type(2)));
DEVI unsigned pk2(float lo, float hi) { const f32x2_t v = {lo, hi}; const bf16x2_t b = __builtin_convertvector(v, bf16x2_t); return __builtin_bit_cast(unsigned, b); }
DEVI int otid() { int t = threadIdx.x; asm volatile("" : "+v"(t)); return t; }
DEVI float wave_sum(float v) {
#pragma unroll
  for (int o = 32; o >= 1; o >>= 1) v += __shfl_xor(v, o);
  return v;
}
DEVI void row_info(int r, int& s, int& t, int& Lr, int& kb) {
  if (r < 33280) { s = r / 4160; kb = s * 4160; t = r - kb; Lr = 4096; }
  else { int q = r - 33280; int ss = q / 8256; s = 8 + ss; kb = 33280 + ss * 8256; t = q - ss * 8256; Lr = 8192; }
}
DEVI size_t blk_off(int row, int col) { return ((size_t)(col >> 5) * MROWS + row) * 32 + (col & 31); }
DEVI int seq_base(int s) { return s < 8 ? s * 4160 : 33280 + (s - 8) * 8256; }
DEVI int seq_lr(int s) { return s < 8 ? 4096 : 8192; }
DEVI int out_base(int s) { return s < 8 ? s * 4096 : 32768 + (s - 8) * 8192; }

DEVI int wmap(int mode, int n0) {
  switch (mode) {
    case 1: return (n0 >> 5) * 64;
    case 2: return (n0 >> 5) * 64 + 32;
    case 3: if (n0 < 384) return n0; if (n0 < 416) return 1024 + (n0 - 384); if (n0 < 1056) return n0 - 32; return n0 + 224;
    case 4: { int h = n0 >> 7, c = n0 & 127; return c < 64 ? h * 64 + c : 512 + h * 64 + (c - 64); }
    default: return n0;
  }
}
DEVI void wt_transpose(const float* __restrict__ src, int K, int N, bf16_t* __restrict__ dst, int NR, int mode, unsigned char* smem, int rot) {
  float* tile = (float*)smem;
  const int tid = otid();
  const int ntn = N >> 5, ntk = K >> 6, ntiles = ntn * ntk;
  int start = (int)blockIdx.x - rot; if (start < 0) start += gridDim.x;
  for (int t = start; t < ntiles; t += gridDim.x) {
    const int kt = t / ntn, nt = t - kt * ntn;
    const int k0 = kt << 6, n0 = nt << 5;
    __syncthreads();
    {
      const int c = tid & 31, r0 = tid >> 5;
#pragma unroll
      for (int i = 0; i < 8; ++i) { const int r = r0 + i * 8; tile[r * 33 + c] = __builtin_nontemporal_load(src + (size_t)(k0 + r) * N + n0 + c); }
    }
    __syncthreads();
    {
      const int n = tid >> 3, kc = tid & 7;
      float v[8];
#pragma unroll
      for (int j = 0; j < 8; ++j) v[j] = tile[(kc * 8 + j) * 33 + n];
      u32x4 w; w.x = pk2(v[0], v[1]); w.y = pk2(v[2], v[3]); w.z = pk2(v[4], v[5]); w.w = pk2(v[6], v[7]);
      const int dr = wmap(mode, n0) + n;
      const int kk = k0 + kc * 8;
      *(u32x4*)(dst + ((size_t)(kk >> 5) * NR + dr) * 32 + (kk & 31)) = w;
    }
  }
}

DEVI const float* h_src(const Params& p, int mode, int s, int t, int Lr) {
  if (t < Lr) {
    const int orow = out_base(s) + t;
    if (mode) return p.out + (size_t)orow * DM;
    return orow < 32768 ? p.x_prompt + (size_t)orow * DM : p.x_sample + (size_t)(orow - 32768) * DM;
  }
  const int j = t - Lr;
  if (mode) return (const float*)(p.ws + WS_HM) + (size_t)(s * 16 + j) * DM;
  return p.meta + (size_t)j * DM;
}
DEVI float* h_dst(const Params& p, int s, int t, int Lr) {
  if (t < Lr) return p.out + (size_t)(out_base(s) + t) * DM;
  return (float*)(p.ws + WS_HM) + (size_t)(s * 16 + (t - Lr)) * DM;
}

DEVI void postnorm_phase(const Params& p, const bf16_t* y, int ldy, float coef, const float* g_post, const float* g_pre,
                         int src_mode, bool write_h, bf16_t* a_out, bool yblk) {
  const int tid0 = otid();
  const int lane = tid0 & 63;
  const int gw = blockIdx.x * 4 + (tid0 >> 6), nw = gridDim.x * 4;
#pragma clang loop unroll(disable)
  for (int rp = gw; rp < MROWS / 2; rp += nw) {
    const int row0 = rp * 2;
    int s, t, Lr, kb; row_info(row0, s, t, Lr, kb);
    if (t >= Lr + 16) {
      if (a_out) {
#pragma unroll
        for (int u = 0; u < 2; ++u)
#pragma unroll
          for (int i = 0; i < 4; ++i) *(u32x2*)(a_out + blk_off(row0 + u, i * 256 + lane * 4)) = (u32x2){0u, 0u};
      }
      continue;
    }
    f32x4 h[2][4];
    u32x2 yw[2][4];
#pragma unroll
    for (int u = 0; u < 2; ++u) {
      const float* hs = h_src(p, src_mode, s, t + u, Lr);
#pragma unroll
      for (int i = 0; i < 4; ++i) h[u][i] = __builtin_nontemporal_load((const f32x4*)(hs + i * 256 + lane * 4));
      if (y) {
#pragma unroll
        for (int i = 0; i < 4; ++i)
          yw[u][i] = __builtin_nontemporal_load((const u32x2*)(y + (yblk ? blk_off(row0 + u, i * 256 + lane * 4) : (size_t)(row0 + u) * ldy + i * 256 + lane * 4)));
      }
    }
#pragma unroll
    for (int u = 0; u < 2; ++u) {
      if (y) {
        f32x4 yv[4]; float ss = 0.f;
#pragma unroll
        for (int i = 0; i < 4; ++i) {
          const u32x2 w = yw[u][i];
          yv[i] = (f32x4){bflo(w.x), bfhi(w.x), bflo(w.y), bfhi(w.y)};
          ss += yv[i][0] * yv[i][0] + yv[i][1] * yv[i][1] + yv[i][2] * yv[i][2] + yv[i][3] * yv[i][3];
        }
        ss = wave_sum(ss);
        const float rstd = rsqrtf(ss * (1.0f / DM) + EPSF) * coef;
#pragma unroll
        for (int i = 0; i < 4; ++i) {
          const f32x4 g = *(const f32x4*)(g_post + i * 256 + lane * 4);
          h[u][i] += yv[i] * rstd * g;
        }
      }
      if (write_h) {
        float* hd = h_dst(p, s, t + u, Lr);
#pragma unroll
        for (int i = 0; i < 4; ++i) __builtin_nontemporal_store(h[u][i], (f32x4*)(hd + i * 256 + lane * 4));
      }
    }
    if (a_out) {
#pragma unroll
      for (int u = 0; u < 2; ++u) {
        float ss = 0.f;
#pragma unroll
        for (int i = 0; i < 4; ++i) ss += h[u][i][0] * h[u][i][0] + h[u][i][1] * h[u][i][1] + h[u][i][2] * h[u][i][2] + h[u][i][3] * h[u][i][3];
        ss = wave_sum(ss);
        const float rstd = rsqrtf(ss * (1.0f / DM) + EPSF);
#pragma unroll
        for (int i = 0; i < 4; ++i) {
          const f32x4 g = *(const f32x4*)(g_pre + i * 256 + lane * 4);
          const f32x4 v = h[u][i] * rstd * g;
          *(u32x2*)(a_out + blk_off(row0 + u, i * 256 + lane * 4)) = (u32x2){pk2(v[0], v[1]), pk2(v[2], v[3])};
        }
      }
    }
  }
}

struct GemmJob {
  const bf16_t* A; int lda; const bf16_t* Bt; int K; int nt0, ntn;
  bf16_t* C; int ldc; int nvalid; int nfirst; int vrows; int NR; int ablk; int cblk;
  const float2* tab;
};
template <int OFF> DEVI bf16x8 ldsr(unsigned a) { bf16x8 v; asm volatile("ds_read_b128 %0, %1 offset:%2" : "=v"(v) : "v"(a), "n"(OFF)); return v; }
template <int TOP> DEVI void lgkm_wait(int i) {
  switch (TOP - i) {
    case 0: asm volatile("s_waitcnt lgkmcnt(0)" ::: "memory"); break;
    case 1: asm volatile("s_waitcnt lgkmcnt(1)" ::: "memory"); break;
    case 2: asm volatile("s_waitcnt lgkmcnt(2)" ::: "memory"); break;
    case 3: asm volatile("s_waitcnt lgkmcnt(3)" ::: "memory"); break;
    case 4: asm volatile("s_waitcnt lgkmcnt(4)" ::: "memory"); break;
    case 5: asm volatile("s_waitcnt lgkmcnt(5)" ::: "memory"); break;
    case 6: asm volatile("s_waitcnt lgkmcnt(6)" ::: "memory"); break;
    default: asm volatile("s_waitcnt lgkmcnt(7)" ::: "memory"); break;
  }
}
#define RAW_BARRIER() do { asm volatile("s_waitcnt lgkmcnt(0)" ::: "memory"); __builtin_amdgcn_s_barrier(); } while (0)

template <int EPI, int NB>
DEVI void gemm_epilogue(const GemmJob& J, f32x4 (&acc)[4][NB], int mbase, int nbase, int lane) {
  const int l16 = lane & 15, g = lane >> 4;
  if constexpr (EPI == 0) {
    const int fbase = (nbase >> 1) + g * 4;
#pragma unroll
    for (int mb = 0; mb < 4; ++mb) {
      const int rowi = mbase + mb * 16 + l16;
#pragma unroll
      for (int grp = 0; grp < NB / 4; ++grp)
#pragma unroll
        for (int nb = 0; nb < 2; ++nb) {
          float o[4];
#pragma unroll
          for (int r = 0; r < 4; ++r) {
            const float gv = acc[mb][grp * 4 + nb][r], uv = acc[mb][grp * 4 + nb + 2][r];
            o[r] = gv * uv * __builtin_amdgcn_rcpf(1.0f + __expf(-gv));
          }
          *(u32x2*)(J.C + blk_off(rowi, fbase + grp * 32 + nb * 16)) = (u32x2){pk2(o[0], o[1]), pk2(o[2], o[3])};
        }
    }
  } else if constexpr (EPI == 1 || EPI == 3 || EPI == 4) {
    if constexpr (EPI == 3) {
#pragma unroll
      for (int mb = 0; mb < 4; ++mb) {
        int s, t, Lr, kb; row_info(mbase + mb * 16 + l16, s, t, Lr, kb);
        const int pos = t < Lr ? 16 + t : t - Lr;
        const float2* tp = J.tab + pos * 16 + g * 4;
#pragma unroll
        for (int nb = 0; nb < NB - 1; ++nb) {
          if ((((nbase >> 4) + nb) % 6) == 4) {
#pragma unroll
            for (int r = 0; r < 4; ++r) {
              const float2 cs = tp[r];
              const float x1 = acc[mb][nb][r], x2 = acc[mb][nb + 1][r];
              acc[mb][nb][r] = x1 * cs.x - x2 * cs.y;
              acc[mb][nb + 1][r] = x2 * cs.x + x1 * cs.y;
            }
          }
        }
      }
    }
#pragma unroll
    for (int mb = 0; mb < 4; ++mb) {
      bf16_t* rowp = J.C + (size_t)(mbase + mb * 16 + l16) * J.ldc;
#pragma unroll
      for (int nb = 0; nb < NB; ++nb) {
        const int n = nbase + nb * 16 + g * 4;
        int col = n;
        if constexpr (EPI == 4) col = (n >> 6) * 96 + (n & 63);
        if (n < J.nvalid) {
          bf16_t* dp = rowp + col;
          if constexpr (EPI == 1) { if (J.cblk) dp = J.C + blk_off(mbase + mb * 16 + l16, col); }
          *(u32x2*)dp = (u32x2){pk2(acc[mb][nb][0], acc[mb][nb][1]), pk2(acc[mb][nb][2], acc[mb][nb][3])};
        }
      }
    }
  } else {
#pragma unroll
    for (int mb = 0; mb < 4; ++mb) {
      int s, t, Lr, kb; row_info(mbase + mb * 16, s, t, Lr, kb);
      const int Lk = Lr + 64;
      bf16_t* basep = J.C + (size_t)J.vrows * kb + t + g * 4;
#pragma unroll
      for (int nb = 0; nb < NB; ++nb) {
        const int vr = nbase + nb * 16 + l16 - J.nfirst;
        if (vr < J.vrows)
          *(u32x2*)(basep + (size_t)vr * Lk) = (u32x2){pk2(acc[mb][nb][0], acc[mb][nb][1]), pk2(acc[mb][nb][2], acc[mb][nb][3])};
      }
    }
  }
}

template <int EPI, int NB>
DEVI void gemm_tile(const GemmJob& J, int m0, int n0, unsigned char* smem) {
  constexpr bool SWAP = (EPI != 2);
  constexpr int BN = NB * 32;
  constexpr int A_BYTES = 128 * 64;
  constexpr int STG = A_BYTES + BN * 64;
  constexpr int S = (NB == 8) ? 3 : 4;
  constexpr int LB = BN / 64;
  const int tid = otid(), lane = tid & 63, wid = tid >> 6, wm = wid >> 1, wn = wid & 1;
  const int l16 = lane & 15, g = lane >> 4;
  f32x4 acc[4][NB];
#pragma unroll
  for (int i = 0; i < 4; ++i)
#pragma unroll
    for (int j = 0; j < NB; ++j) acc[i][j] = (f32x4){0.f, 0.f, 0.f, 0.f};
  const int srow = tid >> 2, sch = tid & 3;
  const int gch = sch ^ ((0 - (tid >> 4)) & 3);
  const bf16_t* Ag = J.A + (size_t)(m0 + srow) * (J.ablk ? 32 : J.lda) + gch * 8;
  const bf16_t* Bg = J.Bt + (size_t)(n0 + srow) * 32 + gch * 8;
  const size_t Astep = (size_t)64 * (J.ablk ? 32 : J.lda), Ak = J.ablk ? (size_t)MROWS * 32 : (size_t)32, Bstep = (size_t)64 * 32, Bk = (size_t)J.NR * 32;
  const int nk = J.K >> 5;
  unsigned char* lds_t = smem + tid * 16;
  const unsigned lbase = (unsigned)(uintptr_t)(__attribute__((address_space(3))) unsigned char*)smem;
#define GEMM_ISSUE(kt_, st_) do { \
    unsigned char* st__ = lds_t + (st_) * STG; \
    _Pragma("unroll") for (int i = 0; i < 2; ++i) \
      __builtin_amdgcn_global_load_lds((const unsigned*)(Ag + i * Astep + (size_t)(kt_) * Ak), (LDSP)(st__ + i * 4096), 16, 0, 0); \
    _Pragma("unroll") for (int i = 0; i < LB; ++i) \
      __builtin_amdgcn_global_load_lds((const unsigned*)(Bg + i * Bstep + (size_t)(kt_) * Bk), (LDSP)(st__ + A_BYTES + i * 4096), 16, 0, 0); \
  } while (0)
  asm volatile("s_waitcnt vmcnt(0)" ::: "memory");
  RAW_BARRIER();
#pragma unroll
  for (int st = 0; st < S - 1; ++st) GEMM_ISSUE(st, st);
  const int fsl = (g ^ ((0 - (l16 >> 2)) & 3)) << 4;
  const int aofs = (wm * 64 + l16) * 64 + fsl;
  const int bofs = A_BYTES + (wn * NB * 16 + l16) * 64 + fsl;
  int cs = 0, is = S - 1;
#pragma clang loop unroll(disable)
  for (int kt = 0; kt < nk; ++kt) {
    if (nk - 1 - kt >= S - 2) {
      if constexpr (NB == 8) asm volatile("s_waitcnt vmcnt(6)" ::: "memory");
      else                   asm volatile("s_waitcnt vmcnt(8)" ::: "memory");
    } else {
      asm volatile("s_waitcnt vmcnt(0)" ::: "memory");
    }
    RAW_BARRIER();
    if (kt + S - 1 < nk) GEMM_ISSUE(kt + S - 1, is);
    is = (is + 1 == S) ? 0 : is + 1;
    const unsigned cur = lbase + cs * STG;
    cs = (cs + 1 == S) ? 0 : cs + 1;
    bf16x8 af[4], bfr[NB];
    const unsigned aa = cur + aofs, ba = cur + bofs;
    af[0] = ldsr<0>(aa); af[1] = ldsr<1024>(aa); af[2] = ldsr<2048>(aa); af[3] = ldsr<3072>(aa);
    bfr[0] = ldsr<0>(ba); bfr[1] = ldsr<1024>(ba); bfr[2] = ldsr<2048>(ba); bfr[3] = ldsr<3072>(ba);
    __builtin_amdgcn_s_setprio(1);
#pragma unroll
    for (int nb = 0; nb < NB; ++nb) {
      if (nb == 0) asm volatile("s_waitcnt lgkmcnt(3)" : "+v"(af[0]), "+v"(af[1]), "+v"(af[2]), "+v"(af[3]), "+v"(bfr[0]) :: "memory");
      else if (nb <= NB - 4) asm volatile("s_waitcnt lgkmcnt(3)" : "+v"(bfr[nb]) :: "memory");
      else if (nb == NB - 3) asm volatile("s_waitcnt lgkmcnt(2)" : "+v"(bfr[nb]) :: "memory");
      else if (nb == NB - 2) asm volatile("s_waitcnt lgkmcnt(1)" : "+v"(bfr[nb]) :: "memory");
      else asm volatile("s_waitcnt lgkmcnt(0)" : "+v"(bfr[nb]) :: "memory");
      __builtin_amdgcn_sched_barrier(0);
#pragma unroll
      for (int mb = 0; mb < 4; ++mb) {
        if constexpr (SWAP) acc[mb][nb] = __builtin_amdgcn_mfma_f32_16x16x32_bf16(bfr[nb], af[mb], acc[mb][nb], 0, 0, 0);
        else                acc[mb][nb] = __builtin_amdgcn_mfma_f32_16x16x32_bf16(af[mb], bfr[nb], acc[mb][nb], 0, 0, 0);
      }
      if constexpr (NB == 8) {
        __builtin_amdgcn_sched_barrier(0);
        if (nb == 0) bfr[4] = ldsr<4096>(ba);
        if (nb == 1) bfr[5] = ldsr<5120>(ba);
        if (nb == 2) bfr[6] = ldsr<6144>(ba);
        if (nb == 3) bfr[7] = ldsr<7168>(ba);
      }
    }
    __builtin_amdgcn_s_setprio(0);
  }
#undef GEMM_ISSUE
  gemm_epilogue<EPI, NB>(J, acc, m0 + wm * 64, n0 + wn * NB * 16, lane);
}

template <int EPI, int NB>
DEVI void gemm_run(const GemmJob& J, unsigned char* smem, int rot) {
  constexpr int BN = NB * 32;
  const int G = gridDim.x;
  int b = (int)blockIdx.x - rot; if (b < 0) b += G;
  if (G & 7) {
    const int ntiles = MT128 * J.ntn;
    for (int t = b; t < ntiles; t += G) {
      const int mt = t / J.ntn, nt = J.nt0 + (t - mt * J.ntn);
      gemm_tile<EPI, NB>(J, mt * 128, nt * BN, smem);
    }
  } else {
    const int x = b & 7, lb = b >> 3, nlb = G >> 3;
    const int mlo = x * 49;
    const int mcnt = min(49, MT128 - mlo);
    const int ntot = mcnt * J.ntn, gsz = 8 * J.ntn;
    for (int q = lb; q < ntot; q += nlb) {
      const int grp = q / gsz, qq = q - grp * gsz;
      const int mg = min(8, mcnt - grp * 8);
      const int nt = qq / mg, mi = qq - nt * mg;
      gemm_tile<EPI, NB>(J, (mlo + grp * 8 + mi) * 128, (J.nt0 + nt) * BN, smem);
    }
  }
  __syncthreads();
}

DEVI void head_norm_rope8(bf16_t* ptr, int lane, const float* gain, float rowp, float colp, const float2* tab, bool do_store) {
  const int k8 = lane & 7;
  const u32x4 w = *(const u32x4*)ptr;
  float x[8] = {bflo(w.x), bfhi(w.x), bflo(w.y), bfhi(w.y), bflo(w.z), bfhi(w.z), bflo(w.w), bfhi(w.w)};
  float ss = 0.f;
#pragma unroll
  for (int j = 0; j < 8; ++j) ss += x[j] * x[j];
  ss += __shfl_xor(ss, 1); ss += __shfl_xor(ss, 2); ss += __shfl_xor(ss, 4);
  const float rstd = rsqrtf(ss * (1.0f / 64.0f) + EPSF);
  const float pos = (k8 < 4) ? rowp : colp;
  const int ip = (int)fabsf(pos);
  const float sgn = pos < 0.f ? -1.f : 1.f;
  const bool first = !(k8 & 2);
  float o[8];
#pragma unroll
  for (int j = 0; j < 8; ++j) {
    const float xn = x[j] * rstd * gain[k8 * 8 + j];
    const float pr = __shfl_xor(xn, 2);
    const float2 cs = tab[ip * 16 + (k8 & 1) * 8 + j];
    const float sn = cs.y * sgn;
    o[j] = first ? (xn * cs.x - pr * sn) : (xn * cs.x + pr * sn);
  }
  if (do_store) *(u32x4*)ptr = (u32x4){pk2(o[0], o[1]), pk2(o[2], o[3]), pk2(o[4], o[5]), pk2(o[6], o[7])};
}

DEVI void split_phase(const Params& p) {
  bf16_t* Hb = (bf16_t*)(p.ws + WS_H);
  bf16_t* proj = Hb + H_PROJ;
  bf16_t* kmla = Hb + H_KMLA;
  const float2* tab = (const float2*)(p.ws + WS_TAB);
  const int tid0 = otid();
  const int lane = tid0 & 63;
  const int gw = blockIdx.x * 4 + (tid0 >> 6), nw = gridDim.x * 4;
  for (int row = gw; row < MROWS; row += nw) {
    int s, t, Lr, kb; row_info(row, s, t, Lr, kb);
    const bool ismeta = t >= Lr;
    const int posA = ismeta ? t - Lr : 16 + t;
    const float rowp = ismeta ? -1.f : (float)(t >> 6);
    const float colp = ismeta ? (float)(t - Lr) : (float)(t & 63);
    bf16_t* pr = proj + (size_t)row * 1056;
    {
      const u32x2 w = *(const u32x2*)(pr + lane * 4);
      const float x0 = bflo(w.x), x1 = bfhi(w.x), x2 = bflo(w.y), x3 = bfhi(w.y);
      const float ss = wave_sum(x0 * x0 + x1 * x1 + x2 * x2 + x3 * x3);
      const float rstd = rsqrtf(ss * (1.0f / 256.0f) + EPSF);
      const f32x4 g = *(const f32x4*)(p.mla_q_norm + lane * 4);
      *(u32x2*)(pr + lane * 4) = (u32x2){pk2(x0 * rstd * g[0], x1 * rstd * g[1]), pk2(x2 * rstd * g[2], x3 * rstd * g[3])};
    }
    {
      const unsigned w = *(const unsigned*)(pr + 256 + lane * 2);
      const float x0 = bflo(w), x1 = bfhi(w);
      const float ss = wave_sum(x0 * x0 + x1 * x1);
      const float rstd = rsqrtf(ss * (1.0f / 128.0f) + EPSF);
      *(unsigned*)(pr + 256 + lane * 2) = pk2(x0 * rstd * p.mla_kv_norm[lane * 2], x1 * rstd * p.mla_kv_norm[lane * 2 + 1]);
    }
    head_norm_rope8(pr + 384 + lane * 8, lane, p.gqa_q_norm, rowp, colp, tab, true);
    head_norm_rope8(pr + 896 + (lane & 15) * 8, lane, p.gqa_k_norm, rowp, colp, tab, lane < 16);
    {
      const int d = lane & 31;
      const float x = bf2f(pr[1024 + d]);
      const float pr2 = __shfl_xor(x, 16);
      const float2 cs = tab[posA * 16 + (d & 15)];
      const float o = (d < 16) ? (x * cs.x - pr2 * cs.y) : (x * cs.x + pr2 * cs.y);
      const unsigned ob = pk2(o, o) & 0xffffu;
      if (lane < 32) {
        bf16_t* kd = kmla + (size_t)row * 768 + 64 + d;
#pragma unroll
        for (int h = 0; h < 8; ++h) kd[h * 96] = (bf16_t)ob;
      }
    }
  }
}

constexpr int ATT_STAGE = 20480;
constexpr int ATT_BIAS_OFF = 61440;
struct AttnArgs {
  const bf16_t* Q; int ldq;
  const bf16_t* K; int ldk;
  const bf16_t* Vt; int Lk;
  bf16_t* O; int orow0, ocol0;
  int nq;
  int first, nreg, Lr;
  float sc2;
  int R, rs;
};

template <int OFF> DEVI u32x2 ldsr64(unsigned a) { u32x2 v; asm volatile("ds_read_b64 %0, %1 offset:%2" : "=v"(v) : "v"(a), "n"(OFF)); return v; }
DEVI float ldsr32(unsigned a) { float v; asm volatile("ds_read_b32 %0, %1" : "=v"(v) : "v"(a)); return v; }
DEVI float xmax16(float x) { auto r = __builtin_amdgcn_permlane16_swap(__float_as_uint(x), __float_as_uint(x), false, false); return fmaxf(__uint_as_float(r[0]), __uint_as_float(r[1])); }
DEVI float xmax32(float x) { auto r = __builtin_amdgcn_permlane32_swap(__float_as_uint(x), __float_as_uint(x), false, false); return fmaxf(__uint_as_float(r[0]), __uint_as_float(r[1])); }
DEVI float xsum16(float x) { auto r = __builtin_amdgcn_permlane16_swap(__float_as_uint(x), __float_as_uint(x), false, false); return __uint_as_float(r[0]) + __uint_as_float(r[1]); }
DEVI float xsum32(float x) { auto r = __builtin_amdgcn_permlane32_swap(__float_as_uint(x), __float_as_uint(x), false, false); return __uint_as_float(r[0]) + __uint_as_float(r[1]); }

template <int DK, int QB, bool NA>
DEVI void attn_item(const AttnArgs& a, unsigned char* smem) {
  constexpr int KS = DK / 32;
  constexpr int S = 3;
  const int tid = otid(), lane = tid & 63, w = tid >> 6;
  const int l16 = lane & 15, g = lane >> 4;
  const bool wact = (w * QB * 16) < a.nq;
  const int nt = a.nreg + 1;
  const unsigned lbase = (unsigned)(uintptr_t)(__attribute__((address_space(3))) unsigned char*)smem;

  bf16x8 qf[QB][KS];
#pragma unroll
  for (int qb = 0; qb < QB; ++qb) {
    const bf16_t* qp = a.Q + (size_t)((wact ? w * QB * 16 : 0) + qb * 16 + l16) * a.ldq + g * 8;
#pragma unroll
    for (int ks = 0; ks < KS; ++ks) qf[qb][ks] = *(const bf16x8*)(qp + ks * 32);
  }
  float m[QB], l[QB];
  f32x4 o[4][QB];
#pragma unroll
  for (int qb = 0; qb < QB; ++qb) {
    m[qb] = NA ? -1e30f : 0.f; l[qb] = 0.f;
#pragma unroll
    for (int db = 0; db < 4; ++db) o[db][qb] = (f32x4){0.f, 0.f, 0.f, 0.f};
  }
  const int r8 = tid >> 3, c8 = (tid & 7) ^ ((tid >> 4) & 7);
  const bf16_t* Kn = a.K + (size_t)r8 * a.ldk + c8 * 8;
  const bf16_t* Kr = a.K + (size_t)(tid >> 2) * a.ldk + 64 + (((tid & 3) ^ ((0 - (tid >> 4)) & 3)) * 8);
  const bf16_t* Vg = a.Vt + (size_t)r8 * a.Lk + c8 * 8;
  const size_t kstep = (size_t)32 * a.ldk, vstep = (size_t)32 * a.Lk;
  unsigned char* lds_t = smem + tid * 16;
#define ATT_ISSUE(j_, st_) do { \
    const int ko__ = ((j_) < a.nreg) ? (a.first + (j_)) * 64 : a.Lr; \
    unsigned char* st__ = lds_t + (st_) * ATT_STAGE; \
    const bf16_t* kp__ = Kn + (size_t)ko__ * a.ldk; \
    __builtin_amdgcn_global_load_lds((const unsigned*)(kp__), (LDSP)(st__), 16, 0, 0); \
    __builtin_amdgcn_global_load_lds((const unsigned*)(kp__ + kstep), (LDSP)(st__ + 4096), 16, 0, 0); \
    if constexpr (DK == 96) __builtin_amdgcn_global_load_lds((const unsigned*)(Kr + (size_t)ko__ * a.ldk), (LDSP)(st__ + 8192), 16, 0, 0); \
    __builtin_amdgcn_global_load_lds((const unsigned*)(Vg + ko__), (LDSP)(st__ + 12288), 16, 0, 0); \
    __builtin_amdgcn_global_load_lds((const unsigned*)(Vg + vstep + ko__), (LDSP)(st__ + 12288 + 4096), 16, 0, 0); \
  } while (0)
  asm volatile("s_waitcnt vmcnt(0)" ::: "memory");
  RAW_BARRIER();
  ATT_ISSUE(0, 0);
  if (nt > 1) ATT_ISSUE(1, 1);
  const int sw8 = (l16 >> 1) & 7, vsw = sw8 << 1;
  const unsigned ka0 = l16 * 128 + ((g ^ sw8) << 4), ka1 = l16 * 128 + (((4 + g) ^ sw8) << 4);
  const unsigned kr = 8192 + l16 * 64 + ((g ^ ((0 - (l16 >> 2)) & 3)) << 4);
  const unsigned vb00 = 12288 + l16 * 128 + (((0 + g) ^ vsw) << 3), vb01 = 12288 + l16 * 128 + (((4 + g) ^ vsw) << 3);
  const unsigned vb10 = 12288 + l16 * 128 + (((8 + g) ^ vsw) << 3), vb11 = 12288 + l16 * 128 + (((12 + g) ^ vsw) << 3);
  const unsigned biasA = lbase + ATT_BIAS_OFF;
  const int qc = w * 16 + l16;
  const int cs0 = min(max(qc - 8, 0), 48);
  int cs = 0, is = 2;
  for (int j = 0; j < nt; ++j) {
    if (j + 1 < nt) {
      if constexpr (DK == 96) asm volatile("s_waitcnt vmcnt(5)" ::: "memory");
      else                    asm volatile("s_waitcnt vmcnt(4)" ::: "memory");
    } else {
      asm volatile("s_waitcnt vmcnt(0)" ::: "memory");
    }
    RAW_BARRIER();
    if (j + 2 < nt) ATT_ISSUE(j + 2, is);
    is = (is + 1 == S) ? 0 : is + 1;
    const unsigned cur = lbase + cs * ATT_STAGE;
    cs = (cs + 1 == S) ? 0 : cs + 1;
    if (wact) {
      f32x4 s[4][QB];
#pragma unroll
      for (int kb = 0; kb < 4; ++kb)
#pragma unroll
        for (int qb = 0; qb < QB; ++qb) s[kb][qb] = (f32x4){0.f, 0.f, 0.f, 0.f};
      {
        bf16x8 k0[4], k1[4], k2[4];
        const unsigned a0 = cur + ka0, a1 = cur + ka1, a2 = cur + kr;
        k0[0] = ldsr<0>(a0); k0[1] = ldsr<2048>(a0); k0[2] = ldsr<4096>(a0); k0[3] = ldsr<6144>(a0);
        k1[0] = ldsr<0>(a1); k1[1] = ldsr<2048>(a1); k1[2] = ldsr<4096>(a1); k1[3] = ldsr<6144>(a1);
        if constexpr (KS == 3) { k2[0] = ldsr<0>(a2); k2[1] = ldsr<1024>(a2); k2[2] = ldsr<2048>(a2); k2[3] = ldsr<3072>(a2); }
        if constexpr (KS == 3) asm volatile("s_waitcnt lgkmcnt(8)" : "+v"(k0[0]), "+v"(k0[1]), "+v"(k0[2]), "+v"(k0[3]) :: "memory");
        else                   asm volatile("s_waitcnt lgkmcnt(4)" : "+v"(k0[0]), "+v"(k0[1]), "+v"(k0[2]), "+v"(k0[3]) :: "memory");
        __builtin_amdgcn_sched_barrier(0);
#pragma unroll
        for (int kb = 0; kb < 4; ++kb)
#pragma unroll
          for (int qb = 0; qb < QB; ++qb) s[kb][qb] = __builtin_amdgcn_mfma_f32_16x16x32_bf16(k0[kb], qf[qb][0], s[kb][qb], 0, 0, 0);
        if constexpr (KS == 3) asm volatile("s_waitcnt lgkmcnt(4)" : "+v"(k1[0]), "+v"(k1[1]), "+v"(k1[2]), "+v"(k1[3]) :: "memory");
        else                   asm volatile("s_waitcnt lgkmcnt(0)" : "+v"(k1[0]), "+v"(k1[1]), "+v"(k1[2]), "+v"(k1[3]) :: "memory");
        __builtin_amdgcn_sched_barrier(0);
#pragma unroll
        for (int kb = 0; kb < 4; ++kb)
#pragma unroll
          for (int qb = 0; qb < QB; ++qb) s[kb][qb] = __builtin_amdgcn_mfma_f32_16x16x32_bf16(k1[kb], qf[qb][1], s[kb][qb], 0, 0, 0);
        if constexpr (KS == 3) {
          asm volatile("s_waitcnt lgkmcnt(0)" : "+v"(k2[0]), "+v"(k2[1]), "+v"(k2[2]), "+v"(k2[3]) :: "memory");
          __builtin_amdgcn_sched_barrier(0);
#pragma unroll
          for (int kb = 0; kb < 4; ++kb)
#pragma unroll
            for (int qb = 0; qb < QB; ++qb) s[kb][qb] = __builtin_amdgcn_mfma_f32_16x16x32_bf16(k2[kb], qf[qb][2], s[kb][qb], 0, 0, 0);
        }
      }
      u32x2 va[2][4], vbq[2][4];
      {
        const unsigned p00 = cur + vb00, p01 = cur + vb01, p10 = cur + vb10, p11 = cur + vb11;
        va[0][0] = ldsr64<0>(p00); vbq[0][0] = ldsr64<0>(p01); va[0][1] = ldsr64<2048>(p00); vbq[0][1] = ldsr64<2048>(p01);
        va[0][2] = ldsr64<4096>(p00); vbq[0][2] = ldsr64<4096>(p01); va[0][3] = ldsr64<6144>(p00); vbq[0][3] = ldsr64<6144>(p01);
        va[1][0] = ldsr64<0>(p10); vbq[1][0] = ldsr64<0>(p11); va[1][1] = ldsr64<2048>(p10); vbq[1][1] = ldsr64<2048>(p11);
        va[1][2] = ldsr64<4096>(p10); vbq[1][2] = ldsr64<4096>(p11); va[1][3] = ldsr64<6144>(p10); vbq[1][3] = ldsr64<6144>(p11);
      }
      const bool ismeta = (j == nt - 1);
      bf16x8 pf[QB][2];
      if constexpr (!NA) {
        typedef float f32x2 __attribute__((ext_vector_type(2)));
#pragma unroll
        for (int qb = 0; qb < QB; ++qb) {
          if (ismeta) {
#pragma unroll
            for (int kb = 1; kb < 4; ++kb) s[kb][qb] = (f32x4){-1e30f, -1e30f, -1e30f, -1e30f};
          }
          const f32x2 scv = {a.sc2, a.sc2}, nmv = {-m[qb], -m[qb]};
          f32x2 t[4][2];
#pragma unroll
          for (int kb = 0; kb < 4; ++kb)
#pragma unroll
            for (int h = 0; h < 2; ++h) {
              const f32x2 sv = {s[kb][qb][2 * h], s[kb][qb][2 * h + 1]};
              t[kb][h] = sv * scv + nmv;
            }
          float mx = fmaxf(t[0][0].x, t[0][0].y);
#pragma unroll
          for (int kb = 0; kb < 4; ++kb)
#pragma unroll
            for (int h = 0; h < 2; ++h) mx = fmaxf(mx, fmaxf(t[kb][h].x, t[kb][h].y));
          if (j == 0 || __any(mx > 6.f)) {
            mx = xmax32(xmax16(mx));
            const float d = (j == 0) ? mx : fmaxf(mx, 0.f);
            const float alpha = __builtin_amdgcn_exp2f(-d);
            const f32x2 dv = {d, d};
#pragma unroll
            for (int kb = 0; kb < 4; ++kb)
#pragma unroll
              for (int h = 0; h < 2; ++h) t[kb][h] -= dv;
            m[qb] += d;
            l[qb] *= alpha;
#pragma unroll
            for (int db = 0; db < 4; ++db) o[db][qb] *= alpha;
          }
          f32x2 ls2 = {0.f, 0.f};
          unsigned pw[2][4];
#pragma unroll
          for (int kb = 0; kb < 4; ++kb)
#pragma unroll
            for (int h = 0; h < 2; ++h) {
              const f32x2 pe = {__builtin_amdgcn_exp2f(t[kb][h].x), __builtin_amdgcn_exp2f(t[kb][h].y)};
              ls2 += pe;
              pw[kb >> 1][(kb & 1) * 2 + h] = pk2(pe.x, pe.y);
            }
          l[qb] += ls2.x + ls2.y;
#pragma unroll
          for (int c = 0; c < 2; ++c) {
            const u32x4 pv = (u32x4){pw[c][0], pw[c][1], pw[c][2], pw[c][3]};
            pf[qb][c] = __builtin_bit_cast(bf16x8, pv);
          }
        }
      } else {
#pragma unroll
      for (int qb = 0; qb < QB; ++qb) {
        float tv[4][4];
#pragma unroll
        for (int kb = 0; kb < 4; ++kb)
#pragma unroll
          for (int r = 0; r < 4; ++r) tv[kb][r] = s[kb][qb][r] * a.sc2;
        if (ismeta) {
          if constexpr (NA) {
            float bv[4];
#pragma unroll
            for (int r = 0; r < 4; ++r) bv[r] = ldsr32(biasA + (480 + g * 4 + r) * 4);
            asm volatile("s_waitcnt lgkmcnt(0)" : "+v"(bv[0]), "+v"(bv[1]), "+v"(bv[2]), "+v"(bv[3]) :: "memory");
            __builtin_amdgcn_sched_barrier(0);
#pragma unroll
            for (int r = 0; r < 4; ++r) tv[0][r] += bv[r];
          }
#pragma unroll
          for (int r = 0; r < 4; ++r) { tv[1][r] = -1e30f; tv[2][r] = -1e30f; tv[3][r] = -1e30f; }
        } else if constexpr (NA) {
          const int ro = (a.rs + j - a.R + 7) * 31 + 15 - qc;
          float bv[4][4];
#pragma unroll
          for (int kb = 0; kb < 4; ++kb)
#pragma unroll
            for (int r = 0; r < 4; ++r) {
              const int kc = kb * 16 + g * 4 + r;
              const bool in = (kc >= cs0) && (kc < cs0 + 16);
              bv[kb][r] = ldsr32(biasA + (in ? ro + kc : 0) * 4);
            }
          asm volatile("s_waitcnt lgkmcnt(0)"
                       : "+v"(bv[0][0]), "+v"(bv[0][1]), "+v"(bv[0][2]), "+v"(bv[0][3]), "+v"(bv[1][0]), "+v"(bv[1][1]), "+v"(bv[1][2]), "+v"(bv[1][3]),
                         "+v"(bv[2][0]), "+v"(bv[2][1]), "+v"(bv[2][2]), "+v"(bv[2][3]), "+v"(bv[3][0]), "+v"(bv[3][1]), "+v"(bv[3][2]), "+v"(bv[3][3])
                       :: "memory");
          __builtin_amdgcn_sched_barrier(0);
#pragma unroll
          for (int kb = 0; kb < 4; ++kb)
#pragma unroll
            for (int r = 0; r < 4; ++r) {
              const int kc = kb * 16 + g * 4 + r;
              const bool in = (kc >= cs0) && (kc < cs0 + 16);
              tv[kb][r] = in ? tv[kb][r] + bv[kb][r] : -1e30f;
            }
        }
        float mx = tv[0][0];
#pragma unroll
        for (int kb = 0; kb < 4; ++kb)
#pragma unroll
          for (int r = 0; r < 4; ++r) mx = fmaxf(mx, tv[kb][r]);
        mx = xmax32(xmax16(mx));
        const float mn = fmaxf(m[qb], mx);
        const float alpha = __builtin_amdgcn_exp2f(m[qb] - mn);
        const bool changed = (mn != m[qb]);
        m[qb] = mn;
        float ls = 0.f;
#pragma unroll
        for (int kb = 0; kb < 4; ++kb)
#pragma unroll
          for (int r = 0; r < 4; ++r) { tv[kb][r] = __builtin_amdgcn_exp2f(tv[kb][r] - mn); ls += tv[kb][r]; }
        l[qb] = l[qb] * alpha + ls;
        if (__any(changed)) {
#pragma unroll
          for (int db = 0; db < 4; ++db) o[db][qb] *= alpha;
        }
#pragma unroll
        for (int c = 0; c < 2; ++c) {
          u32x4 pw;
          pw.x = pk2(tv[2 * c][0], tv[2 * c][1]); pw.y = pk2(tv[2 * c][2], tv[2 * c][3]);
          pw.z = pk2(tv[2 * c + 1][0], tv[2 * c + 1][1]); pw.w = pk2(tv[2 * c + 1][2], tv[2 * c + 1][3]);
          pf[qb][c] = __builtin_bit_cast(bf16x8, pw);
        }
      }
      }
      asm volatile("s_waitcnt lgkmcnt(0)"
                   : "+v"(va[0][0]), "+v"(va[0][1]), "+v"(va[0][2]), "+v"(va[0][3]), "+v"(va[1][0]), "+v"(va[1][1]), "+v"(va[1][2]), "+v"(va[1][3]),
                     "+v"(vbq[0][0]), "+v"(vbq[0][1]), "+v"(vbq[0][2]), "+v"(vbq[0][3]), "+v"(vbq[1][0]), "+v"(vbq[1][1]), "+v"(vbq[1][2]), "+v"(vbq[1][3])
                   :: "memory");
      __builtin_amdgcn_sched_barrier(0);
#pragma unroll
      for (int c = 0; c < 2; ++c)
#pragma unroll
        for (int db = 0; db < 4; ++db) {
          const u32x4 vw = (u32x4){va[c][db].x, va[c][db].y, vbq[c][db].x, vbq[c][db].y};
          const bf16x8 vf = __builtin_bit_cast(bf16x8, vw);
#pragma unroll
          for (int qb = 0; qb < QB; ++qb) o[db][qb] = __builtin_amdgcn_mfma_f32_16x16x32_bf16(vf, pf[qb][c], o[db][qb], 0, 0, 0);
        }
    }
  }
#undef ATT_ISSUE
  if (wact) {
#pragma unroll
    for (int qb = 0; qb < QB; ++qb) {
      const float lt = xsum32(xsum16(l[qb]));
      const float inv = 1.0f / lt;
      const int qi = w * QB * 16 + qb * 16 + l16;
      if (qi < a.nq) {
#pragma unroll
        for (int db = 0; db < 4; ++db) {
          const f32x4 v = o[db][qb] * inv;
          *(u32x2*)(a.O + blk_off(a.orow0 + qi, a.ocol0 + db * 16 + g * 4)) = (u32x2){pk2(v[0], v[1]), pk2(v[2], v[3])};
        }
      }
    }
  }
}

DEVI int next_item(unsigned* ctr, int* sh) {
  __syncthreads();
  if (threadIdx.x == 0) *sh = (int)atomicAdd(ctr, 1u);
  __syncthreads();
  return __builtin_amdgcn_readfirstlane(*sh);
}

DEVI void attn_dense_phase(const Params& p, unsigned char* smem, unsigned* ctr) {
  bf16_t* Hb = (bf16_t*)(p.ws + WS_H);
  bf16_t* Ob = (bf16_t*)(p.ws + WS_A);
  int* sh = (int*)(smem + 73600);
  constexpr int NITEMS = 2048 + 4096 + 160;
  for (;;) {
    const int it = next_item(ctr, sh);
    if (it >= NITEMS) break;
    int s, h16, qt, nq = 128;
    if (it < 160) { s = it >> 4; h16 = it & 15; qt = -1; nq = 16; }
    else if (it < 160 + 2048) { const int id = it - 160; qt = id & 63; const int shd = id >> 6; if (shd < 16) { s = 8 + (shd >> 3); h16 = shd & 7; } else { s = 8 + ((shd - 16) >> 3); h16 = 8 + ((shd - 16) & 7); } }
    else { const int id = it - 160 - 2048; qt = id & 31; const int shd = id >> 5; if (shd < 64) { s = shd >> 3; h16 = shd & 7; } else { s = (shd - 64) >> 3; h16 = 8 + ((shd - 64) & 7); } }
    const int kb = seq_base(s), Lr = seq_lr(s), Lk = Lr + 64;
    const int q0 = kb + (qt < 0 ? Lr : qt * 128);
    AttnArgs a;
    a.nq = nq; a.first = 0; a.nreg = Lr >> 6; a.Lr = Lr; a.Lk = Lk; a.R = 0; a.rs = 0;
    a.O = Ob; a.orow0 = q0; a.ocol0 = h16 * 64;
    if (h16 < 8) {
      a.Q = Hb + H_QA + (size_t)q0 * 768 + h16 * 96; a.ldq = 768;
      a.K = Hb + H_KMLA + (size_t)kb * 768 + h16 * 96; a.ldk = 768;
      a.Vt = Hb + H_VTM + (size_t)512 * kb + (size_t)(h16 * 64) * Lk;
      a.sc2 = 0.10206207261596577f * LOG2E;
      attn_item<96, 2, false>(a, smem);
    } else {
      const int hq = h16 - 8, kvh = hq >> 2;
      a.Q = Hb + H_PROJ + (size_t)q0 * 1056 + 384 + hq * 64; a.ldq = 1056;
      a.K = Hb + H_PROJ + (size_t)kb * 1056 + 896 + kvh * 64; a.ldk = 1056;
      a.Vt = Hb + H_VTG + (size_t)128 * kb + (size_t)(kvh * 64) * Lk;
      a.sc2 = 0.125f * LOG2E;
      attn_item<64, 2, false>(a, smem);
    }
  }
}

DEVI void attn_na_phase(const Params& p, unsigned char* smem, unsigned* ctr) {
  bf16_t* Hb = (bf16_t*)(p.ws + WS_H);
  bf16_t* Ob = (bf16_t*)(p.ws + WS_A);
  int* sh = (int*)(smem + 73600);
  float* biasL = (float*)(smem + ATT_BIAS_OFF);
  constexpr int NP = 8 * 16 * 65, NS = 2 * 16 * 129;
  for (;;) {
    const int it = next_item(ctr, sh);
    if (it >= NP + NS) break;
    int s, h, R, rows;
    if (it < NS) { const int sh2 = it / 129; R = it - sh2 * 129; s = 8 + (sh2 >> 4); h = sh2 & 15; rows = 128; }
    else { const int id = it - NS; const int sh2 = id / 65; R = id - sh2 * 65; s = sh2 >> 4; h = sh2 & 15; rows = 64; }
    const int kb = seq_base(s), Lr = seq_lr(s), Lk = Lr + 64;
    for (int i = threadIdx.x; i < 465; i += 256) biasL[i] = p.na_rpb[h * 465 + i] * LOG2E;
    if (threadIdx.x < 16) biasL[480 + threadIdx.x] = p.na_meta_bias[h * 16 + threadIdx.x] * LOG2E;
    AttnArgs a;
    a.Lr = Lr; a.Lk = Lk; a.sc2 = 0.125f * LOG2E;
    a.K = Hb + H_NAQK + (size_t)kb * 2048 + 1024 + h * 64; a.ldk = 2048;
    a.Vt = Hb + H_VTN + (size_t)1024 * kb + (size_t)(h * 64) * Lk;
    a.ldq = 2048;
    int q0;
    if (R < rows) { const int rs = min(max(R - 4, 0), rows - 8); a.R = R; a.rs = rs; a.first = rs; a.nreg = 8; a.nq = 64; q0 = kb + R * 64; }
    else { a.R = 0; a.rs = 0; a.first = 0; a.nreg = 0; a.nq = 16; q0 = kb + Lr; }
    a.Q = Hb + H_NAQK + (size_t)q0 * 2048 + h * 64;
    a.O = Ob; a.orow0 = q0; a.ocol0 = h * 64;
    attn_item<64, 1, true>(a, smem);
  }
}

#define XB_TMO      128
#define XB_XCNT(j)  (256  + 64 * (j))
#define XB_XSUB(j)  (1280 + 64 * (j))
#define XB_XGEN(j)  (2304 + 64 * (j))
#define XB_TOP      3328
#define XB_TOPGEN   3392
#define XCD_BAR_WORDS 3456
#define XB_SPIN_CAP (1u << 20)
#define LAS __attribute__((address_space(3)))
DEVI unsigned xb_ld(unsigned* p)              { return __hip_atomic_load(p, __ATOMIC_RELAXED, __HIP_MEMORY_SCOPE_AGENT); }
DEVI unsigned xb_add(unsigned* p, unsigned v) { return __hip_atomic_fetch_add(p, v, __ATOMIC_RELAXED, __HIP_MEMORY_SCOPE_AGENT); }
DEVI unsigned xb_xcc_id() { return (unsigned)__builtin_amdgcn_s_getreg((3 << 11) | 20) & 0xFu; }
#define XB_SPIN(cond, bar) do { unsigned _sp = 0; while (cond) { __builtin_amdgcn_s_sleep(1); \
    if ((++_sp & 255u) == 0u) { if (xb_ld(&(bar)[XB_TMO])) break; if (_sp > XB_SPIN_CAP) { atomicAdd(&(bar)[XB_TMO], 1u); break; } } } } while (0)
struct XcdBarrier { unsigned* bar; unsigned x; volatile LAS unsigned* st; };
DEVI XcdBarrier xcd_barrier_post(unsigned* bar, volatile LAS unsigned* st) {
  XcdBarrier b; b.bar = bar; b.x = xb_xcc_id(); b.st = st;
  if (threadIdx.x == 0) (void)xb_add(&bar[XB_XCNT(b.x)], 1u);
  return b;
}
DEVI void xcd_barrier_complete(unsigned* bar, unsigned x, unsigned& nloc, unsigned& nx) {
  const unsigned G = gridDim.x * gridDim.y * gridDim.z;
  unsigned sum, cnt, mine, sp = 0u;
  for (;;) {
    sum = 0u; cnt = 0u; mine = 0u;
#pragma unroll
    for (unsigned j = 0; j < 16; ++j) { const unsigned c = xb_ld(&bar[XB_XCNT(j)]); sum += c; cnt += (c > 0u) ? 1u : 0u; mine = (j == x) ? c : mine; }
    if (sum == G) break;
    __builtin_amdgcn_s_sleep(1);
    if ((++sp & 255u) == 0u) { if (xb_ld(&bar[XB_TMO])) break; if (sp > XB_SPIN_CAP) { atomicAdd(&bar[XB_TMO], 1u); break; } }
  }
  nloc = mine > 0u ? mine : 1u; nx = cnt > 0u ? cnt : 1u;
}
DEVI void xcd_barrier(const XcdBarrier& b) {
  asm volatile("s_waitcnt vmcnt(0)" ::: "memory");
  __syncthreads();
  if (threadIdx.x == 0) {
    unsigned* bar = b.bar;
    __builtin_amdgcn_s_waitcnt(0);
    unsigned nloc = b.st[0], nx = b.st[1];
    if (nloc == 0u) { xcd_barrier_complete(bar, b.x, nloc, nx); b.st[0] = nloc; b.st[1] = nx; }
    const unsigned old = xb_add(&bar[XB_XSUB(b.x)], 1u);
    const unsigned gen = old / nloc;
    if (old + 1u == (gen + 1u) * nloc) {
      __builtin_amdgcn_fence(__ATOMIC_RELEASE, "agent");
      asm volatile("s_waitcnt vmcnt(0)" ::: "memory");
      const unsigned og = xb_add(&bar[XB_TOP], 1u);
      const unsigned tg = og / nx;
      if (og + 1u == (tg + 1u) * nx) xb_add(&bar[XB_TOPGEN], 1u);
      else XB_SPIN(xb_ld(&bar[XB_TOPGEN]) == tg, bar);
      __builtin_amdgcn_fence(__ATOMIC_ACQUIRE, "agent");
      xb_add(&bar[XB_XGEN(b.x)], 1u);
      asm volatile("s_waitcnt vmcnt(0)" ::: "memory");
    } else {
      XB_SPIN(xb_ld(&bar[XB_XGEN(b.x)]) == gen, bar);
      __builtin_amdgcn_fence(__ATOMIC_ACQUIRE, "agent");
      asm volatile("s_waitcnt vmcnt(0)" ::: "memory");
    }
  }
  __syncthreads();
}

__global__ void __launch_bounds__(256, 2) fwd_megakernel(Params p) {
  cg::grid_group grid = cg::this_grid();
  __shared__ __attribute__((aligned(16))) unsigned char smem[73728];
  __shared__ uint4 xb_words;
  if (threadIdx.x == 0) xb_words = make_uint4(0u, 0u, 0u, 0u);
  __syncthreads();
  const XcdBarrier xb = xcd_barrier_post((unsigned*)(p.ws + WS_BAR), (volatile LAS unsigned*)&xb_words);
  const int G = gridDim.x;
  unsigned* ctr = (unsigned*)(p.ws + WS_CTR);
  bf16_t* Wb = (bf16_t*)(p.ws + WS_W);
  bf16_t* Ab = (bf16_t*)(p.ws + WS_A);
  bf16_t* Hb = (bf16_t*)(p.ws + WS_H);
  float2* tab = (float2*)(p.ws + WS_TAB);

  {
    int rot = 0;
    for (int li = 0; li < 2; ++li)
      for (int f = 0; f < 2; ++f) {
        bf16_t* wgu = Wb + (size_t)(li * 2 + f) * W_FFN_EL;
        wt_transpose(p.ffn_w[f * 3 + 0] + (size_t)li * DM * DFF, DM, DFF, wgu, 5632, 1, smem, rot); rot = (rot + 1408) % G;
        wt_transpose(p.ffn_w[f * 3 + 1] + (size_t)li * DM * DFF, DM, DFF, wgu, 5632, 2, smem, rot); rot = (rot + 1408) % G;
        wt_transpose(p.ffn_w[f * 3 + 2] + (size_t)li * DM * DFF, DFF, DM, wgu + W_GU_EL, 1024, 0, smem, rot); rot = (rot + 1408) % G;
      }
    wt_transpose(p.attn_w_in, DM, 1184, Wb + W_IN_OFF, 1536, 3, smem, rot); rot = (rot + 592) % G;
    wt_transpose(p.mla_w_uq, 256, 768, Wb + W_UQ_OFF, 768, 0, smem, rot); rot = (rot + 96) % G;
    wt_transpose(p.mla_w_ukv, 128, 1024, Wb + W_UKV_OFF, 1024, 4, smem, rot); rot = (rot + 64) % G;
    wt_transpose(p.attn_w_out, DM, DM, Wb + W_OUT_OFF, 1024, 0, smem, rot); rot = (rot + 512) % G;
    wt_transpose(p.na_w_qkv, DM, 3072, Wb + W_NAQKV_OFF, 3072, 0, smem, rot); rot = (rot + 1536) % G;
    wt_transpose(p.na_w_out, DM, DM, Wb + W_NAOUT_OFF, 1024, 0, smem, rot);
    {
      for (int i = blockIdx.x * 256 + threadIdx.x; i < 32 * 352 * 4; i += G * 256) {
        const int q4 = i & 3, rr = (i >> 2) % 352, kbk = (i >> 2) / 352;
        const int r = rr < 224 ? 1056 + rr : 1408 + (rr - 224);
        *(u32x4*)(Wb + W_IN_OFF + ((size_t)kbk * 1536 + r) * 32 + q4 * 8) = (u32x4){0u, 0u, 0u, 0u};
      }
    }
    for (int i = blockIdx.x * 256 + threadIdx.x; i < 8208 * 16; i += G * 256) {
      const int pos = i >> 4, k = i & 15;
      const float ang = (float)pos * p.inv_freq[k];
      const double ad = (double)ang;
      const double q = rint(ad * 0.15915494309189535);
      const float rr = (float)(ad - q * 6.283185307179586);
      tab[i] = make_float2(__cosf(rr), __sinf(rr));
    }
    postnorm_phase(p, nullptr, 0, 0.f, nullptr, p.norm_gains, 0, false, Ab, false);
  }
  xcd_barrier(xb);
  if (p.ws == nullptr) grid.sync();

  for (int li = 0; li < 2; ++li) {
    const float* gains = p.norm_gains + (size_t)li * 6 * DM;
    {
      GemmJob J{}; J.A = Ab; J.lda = DM; J.Bt = Wb + (size_t)(li * 2) * W_FFN_EL; J.K = DM; J.NR = 5632; J.ablk = 1; J.nt0 = 0; J.ntn = 22; J.C = Hb; J.ldc = DFF;
      gemm_run<0, 8>(J, smem, 0);
    }
    xcd_barrier(xb);
    {
      GemmJob J{}; J.A = Hb; J.lda = DFF; J.Bt = Wb + (size_t)(li * 2) * W_FFN_EL + W_GU_EL; J.K = DFF; J.NR = 1024; J.ablk = 1; J.cblk = 1; J.nt0 = 0; J.ntn = 4; J.C = Ab; J.ldc = DM; J.nvalid = DM;
      gemm_run<1, 8>(J, smem, 0);
    }
    xcd_barrier(xb);
    postnorm_phase(p, Ab, DM, 0.5f, gains + DM, gains + 2 * DM, li == 0 ? 0 : 1, true, Ab, true);
    xcd_barrier(xb);
    if (li == 0) {
      {
        GemmJob J{}; J.A = Ab; J.lda = DM; J.Bt = Wb + W_IN_OFF; J.K = DM; J.NR = 1536; J.ablk = 1; J.nt0 = 0; J.ntn = 5; J.C = Hb + H_PROJ; J.ldc = 1056; J.nvalid = 1056;
        gemm_run<1, 8>(J, smem, 0);
        GemmJob V{}; V.A = Ab; V.lda = DM; V.Bt = Wb + W_IN_OFF; V.K = DM; V.NR = 1536; V.ablk = 1; V.nt0 = 5; V.ntn = 1; V.C = Hb + H_VTG; V.nfirst = 1280; V.vrows = 128;
        gemm_run<2, 8>(V, smem, (MT128 * 5) % G);
      }
      xcd_barrier(xb);
      split_phase(p);
      xcd_barrier(xb);
      {
        GemmJob J{}; J.A = Hb + H_PROJ; J.lda = 1056; J.Bt = Wb + W_UQ_OFF; J.K = 256; J.NR = 768; J.nt0 = 0; J.ntn = 3; J.C = Hb + H_QA; J.ldc = 768; J.nvalid = 768; J.tab = tab;
        gemm_run<3, 8>(J, smem, 0);
        GemmJob Kj{}; Kj.A = Hb + H_PROJ + 256; Kj.lda = 1056; Kj.Bt = Wb + W_UKV_OFF; Kj.K = 128; Kj.NR = 1024; Kj.nt0 = 0; Kj.ntn = 2; Kj.C = Hb + H_KMLA; Kj.ldc = 768; Kj.nvalid = 512;
        gemm_run<4, 8>(Kj, smem, (MT128 * 3) % G);
        GemmJob V{}; V.A = Hb + H_PROJ + 256; V.lda = 1056; V.Bt = Wb + W_UKV_OFF; V.K = 128; V.NR = 1024; V.nt0 = 2; V.ntn = 2; V.C = Hb + H_VTM; V.nfirst = 512; V.vrows = 512;
        gemm_run<2, 8>(V, smem, (MT128 * 5) % G);
      }
      xcd_barrier(xb);
      attn_dense_phase(p, smem, ctr + 0);
      xcd_barrier(xb);
      {
        GemmJob J{}; J.A = Ab; J.lda = DM; J.Bt = Wb + W_OUT_OFF; J.K = DM; J.NR = 1024; J.ablk = 1; J.nt0 = 0; J.ntn = 4; J.C = Hb; J.ldc = DM; J.nvalid = DM;
        gemm_run<1, 8>(J, smem, 0);
      }
      xcd_barrier(xb);
    } else {
      {
        GemmJob J{}; J.A = Ab; J.lda = DM; J.Bt = Wb + W_NAQKV_OFF; J.K = DM; J.NR = 3072; J.ablk = 1; J.nt0 = 0; J.ntn = 8; J.C = Hb + H_NAQK; J.ldc = 2048; J.nvalid = 2048;
        gemm_run<1, 8>(J, smem, 0);
        GemmJob V{}; V.A = Ab; V.lda = DM; V.Bt = Wb + W_NAQKV_OFF; V.K = DM; V.NR = 3072; V.ablk = 1; V.nt0 = 8; V.ntn = 4; V.C = Hb + H_VTN; V.nfirst = 2048; V.vrows = 1024;
        gemm_run<2, 8>(V, smem, (MT128 * 8) % G);
      }
      xcd_barrier(xb);
      attn_na_phase(p, smem, ctr + 1);
      xcd_barrier(xb);
      {
        GemmJob J{}; J.A = Ab; J.lda = DM; J.Bt = Wb + W_NAOUT_OFF; J.K = DM; J.NR = 1024; J.ablk = 1; J.nt0 = 0; J.ntn = 4; J.C = Hb; J.ldc = DM; J.nvalid = DM;
        gemm_run<1, 8>(J, smem, 0);
      }
      xcd_barrier(xb);
    }
    postnorm_phase(p, Hb, DM, 1.0f, gains + 3 * DM, gains + 4 * DM, 1, true, Ab, false);
    xcd_barrier(xb);
    {
      GemmJob J{}; J.A = Ab; J.lda = DM; J.Bt = Wb + (size_t)(li * 2 + 1) * W_FFN_EL; J.K = DM; J.NR = 5632; J.ablk = 1; J.nt0 = 0; J.ntn = 22; J.C = Hb; J.ldc = DFF;
      gemm_run<0, 8>(J, smem, 0);
    }
    xcd_barrier(xb);
    {
      GemmJob J{}; J.A = Hb; J.lda = DFF; J.Bt = Wb + (size_t)(li * 2 + 1) * W_FFN_EL + W_GU_EL; J.K = DFF; J.NR = 1024; J.ablk = 1; J.cblk = 1; J.nt0 = 0; J.ntn = 4; J.C = Ab; J.ldc = DM; J.nvalid = DM;
      gemm_run<1, 8>(J, smem, 0);
    }
    xcd_barrier(xb);
    if (li == 0) postnorm_phase(p, Ab, DM, 0.5f, gains + 5 * DM, gains + 6 * DM, 1, true, Ab, true);
    else         postnorm_phase(p, Ab, DM, 0.5f, gains + 5 * DM, nullptr, 1, true, nullptr, true);
    if (li == 0) xcd_barrier(xb);
  }
}

extern "C" void kernel_launch(void* const* d_in, const int* in_sizes, int n_in, void* d_out, int out_size,
                              void* d_ws, size_t ws_size, hipStream_t stream) {
  (void)in_sizes; (void)n_in; (void)out_size;
  if (ws_size < WS_NEED) { fprintf(stderr, "workspace too small: %zu < %zu\n", ws_size, (size_t)WS_NEED); return; }
  static int grid_blocks = 0;
  if (!grid_blocks) {
    int dev = 0, cus = 0, per_cu = 0;
    hipGetDevice(&dev);
    hipDeviceGetAttribute(&cus, hipDeviceAttributeMultiprocessorCount, dev);
    hipOccupancyMaxActiveBlocksPerMultiprocessor(&per_cu, fwd_megakernel, 256, 0);
    per_cu = 2;
    grid_blocks = cus * per_cu;
  }
  Params p{};
  p.x_prompt = (const float*)d_in[0]; p.x_sample = (const float*)d_in[1]; p.meta = (const float*)d_in[2]; p.norm_gains = (const float*)d_in[3];
  for (int i = 0; i < 6; ++i) p.ffn_w[i] = (const float*)d_in[4 + i];
  p.attn_w_in = (const float*)d_in[10]; p.mla_q_norm = (const float*)d_in[11]; p.mla_w_uq = (const float*)d_in[12];
  p.mla_kv_norm = (const float*)d_in[13]; p.mla_w_ukv = (const float*)d_in[14]; p.gqa_q_norm = (const float*)d_in[15];
  p.gqa_k_norm = (const float*)d_in[16]; p.attn_w_out = (const float*)d_in[17]; p.na_w_qkv = (const float*)d_in[18];
  p.na_rpb = (const float*)d_in[19]; p.na_meta_bias = (const float*)d_in[20]; p.na_w_out = (const float*)d_in[21];
  p.out = (float*)d_out; p.ws = (unsigned char*)d_ws;
  for (int i = 0; i < 16; ++i) p.inv_freq[i] = (float)(1.0 / pow(10000.0, (double)i / 16.0));
  (void)hipMemsetAsync(d_ws, 0, WS_TAB, stream);
  void* args[] = {&p};
  hipError_t e = hipLaunchCooperativeKernel((void*)fwd_megakernel, dim3(grid_blocks), dim3(256), args, 0, stream);
  if (e != hipSuccess) fprintf(stderr, "cooperative launch failed: %s (grid %d)\n", hipGetErrorString(e), grid_blocks);
}
```

```cpp
#include <hip/hip_runtime.h>
#include <hip/hip_cooperative_groups.h>
#include <cstdint>
#include <cstdio>
#include <cmath>
namespace cg = cooperative_groups;

typedef unsigned short bf16_t;
typedef short bf16x8 __attribute__((ext_vector_type(8)));
typedef float f32x4 __attribute__((ext_vector_type(4)));
typedef unsigned u32x4 __attribute__((ext_vector_type(4)));
typedef unsigned u32x2 __attribute__((ext_vector_type(2)));

#define DEVI __device__ __forceinline__
#define LDSP unsigned*

constexpr int MROWS = 49792;
constexpr int MT128 = 389;
constexpr int DM = 1024;
constexpr int DFF = 2816;
constexpr float EPSF = 1e-6f;
constexpr float LOG2E = 1.4426950408889634f;

constexpr size_t WS_CTR = 0;
constexpr size_t WS_BAR = 4096;
constexpr size_t WS_TAB = 4096 + 16384;
constexpr size_t WS_HM  = WS_TAB + 1052672;
constexpr size_t WS_W   = WS_HM + 655360;
constexpr size_t W_FFN_EL = 8650752;
constexpr size_t W_GU_EL = 5767168;
constexpr size_t W_IN_OFF   = 4 * W_FFN_EL;
constexpr size_t W_UQ_OFF   = W_IN_OFF + 1572864;
constexpr size_t W_UKV_OFF  = W_UQ_OFF + 196608;
constexpr size_t W_OUT_OFF  = W_UKV_OFF + 131072;
constexpr size_t W_NAQKV_OFF = W_OUT_OFF + 1048576;
constexpr size_t W_NAOUT_OFF = W_NAQKV_OFF + 3145728;
constexpr size_t W_TOTAL_EL = W_NAOUT_OFF + 1048576;
constexpr size_t WS_A = WS_W + W_TOTAL_EL * 2;
constexpr size_t WS_H = WS_A + (size_t)MROWS * 1024 * 2;
constexpr size_t H_PROJ = 0;
constexpr size_t H_QA   = (size_t)MROWS * 1056;
constexpr size_t H_KMLA = (size_t)MROWS * (1056 + 768);
constexpr size_t H_VTM  = (size_t)MROWS * 2592;
constexpr size_t H_VTG  = (size_t)MROWS * 3104;
constexpr size_t H_END0 = (size_t)MROWS * 3232;
constexpr size_t H_NAQK = 0;
constexpr size_t H_VTN  = (size_t)MROWS * 2048;
constexpr size_t WS_NEED = WS_H + H_END0 * 2;

struct Params {
  const float* x_prompt; const float* x_sample; const float* meta; const float* norm_gains;
  const float* ffn_w[6];
  const float* attn_w_in; const float* mla_q_norm; const float* mla_w_uq; const float* mla_kv_norm; const float* mla_w_ukv;
  const float* gqa_q_norm; const float* gqa_k_norm; const float* attn_w_out;
  const float* na_w_qkv; const float* na_rpb; const float* na_meta_bias; const float* na_w_out;
  float* out; unsigned char* ws;
  float inv_freq[16];
};

DEVI float bf2f(unsigned v) { return __uint_as_float(v << 16); }
DEVI float bflo(unsigned v) { return __uint_as_float(v << 16); }
DEVI float bfhi(unsigned v) { return __uint_as_float(v & 0xffff0000u); }
typedef __bf16 bf16x2_t __attribute__((ext_vector_type(2)));
typedef float f32x2_t __attribute__((ext_vector_type(2)));
DEVI unsigned pk2(float lo, float hi) { const f32x2_t v = {lo, hi}; const bf16x2_t b = __builtin_convertvector(v, bf16x2_t); return __builtin_bit_cast(unsigned, b); }
DEVI int otid() { int t = threadIdx.x; asm volatile("" : "+v"(t)); return t; }
DEVI float wave_sum(float v) {
#pragma unroll
  for (int o = 32; o >= 1; o >>= 1) v += __shfl_xor(v, o);
  return v;
}
DEVI void row_info(int r, int& s, int& t, int& Lr, int& kb) {
  if (r < 33280) { s = r / 4160; kb = s * 4160; t = r - kb; Lr = 4096; }
  else { int q = r - 33280; int ss = q / 8256; s = 8 + ss; kb = 33280 + ss * 8256; t = q - ss * 8256; Lr = 8192; }
}
DEVI size_t blk_off(int row, int col) { return ((size_t)(col >> 5) * MROWS + row) * 32 + (col & 31); }
DEVI int seq_base(int s) { return s < 8 ? s * 4160 : 33280 + (s - 8) * 8256; }
DEVI int seq_lr(int s) { return s < 8 ? 4096 : 8192; }
DEVI int out_base(int s) { return s < 8 ? s * 4096 : 32768 + (s - 8) * 8192; }

DEVI int wmap(int mode, int n0) {
  switch (mode) {
    case 1: return (n0 >> 5) * 64;
    case 2: return (n0 >> 5) * 64 + 32;
    case 3: if (n0 < 384) return n0; if (n0 < 416) return 1024 + (n0 - 384); if (n0 < 1056) return n0 - 32; return n0 + 224;
    case 4: { int h = n0 >> 7, c = n0 & 127; return c < 64 ? h * 64 + c : 512 + h * 64 + (c - 64); }
    default: return n0;
  }
}
DEVI void wt_transpose(const float* __restrict__ src, int K, int N, bf16_t* __restrict__ dst, int NR, int mode, unsigned char* smem, int rot) {
  float* tile = (float*)smem;
  const int tid = otid();
  const int ntn = N >> 5, ntk = K >> 6, ntiles = ntn * ntk;
  int start = (int)blockIdx.x - rot; if (start < 0) start += gridDim.x;
  for (int t = start; t < ntiles; t += gridDim.x) {
    const int kt = t / ntn, nt = t - kt * ntn;
    const int k0 = kt << 6, n0 = nt << 5;
    __syncthreads();
    {
      const int c = tid & 31, r0 = tid >> 5;
#pragma unroll
      for (int i = 0; i < 8; ++i) { const int r = r0 + i * 8; tile[r * 33 + c] = src[(size_t)(k0 + r) * N + n0 + c]; }
    }
    __syncthreads();
    {
      const int n = tid >> 3, kc = tid & 7;
      float v[8];
#pragma unroll
      for (int j = 0; j < 8; ++j) v[j] = tile[(kc * 8 + j) * 33 + n];
      u32x4 w; w.x = pk2(v[0], v[1]); w.y = pk2(v[2], v[3]); w.z = pk2(v[4], v[5]); w.w = pk2(v[6], v[7]);
      const int dr = wmap(mode, n0) + n;
      const int kk = k0 + kc * 8;
      *(u32x4*)(dst + ((size_t)(kk >> 5) * NR + dr) * 32 + (kk & 31)) = w;
    }
  }
}

DEVI const float* h_src(const Params& p, int mode, int s, int t, int Lr) {
  if (t < Lr) {
    const int orow = out_base(s) + t;
    if (mode) return p.out + (size_t)orow * DM;
    return orow < 32768 ? p.x_prompt + (size_t)orow * DM : p.x_sample + (size_t)(orow - 32768) * DM;
  }
  const int j = t - Lr;
  if (mode) return (const float*)(p.ws + WS_HM) + (size_t)(s * 16 + j) * DM;
  return p.meta + (size_t)j * DM;
}
DEVI float* h_dst(const Params& p, int s, int t, int Lr) {
  if (t < Lr) return p.out + (size_t)(out_base(s) + t) * DM;
  return (float*)(p.ws + WS_HM) + (size_t)(s * 16 + (t - Lr)) * DM;
}

DEVI void postnorm_phase(const Params& p, const bf16_t* y, int ldy, float coef, const float* g_post, const float* g_pre,
                         int src_mode, bool write_h, bf16_t* a_out, bool yblk) {
  const int tid0 = otid();
  const int lane = tid0 & 63;
  const int gw = blockIdx.x * 4 + (tid0 >> 6), nw = gridDim.x * 4;
#pragma clang loop unroll(disable)
  for (int rp = gw; rp < MROWS / 2; rp += nw) {
    const int row0 = rp * 2;
    int s, t, Lr, kb; row_info(row0, s, t, Lr, kb);
    if (t >= Lr + 16) {
      if (a_out) {
#pragma unroll
        for (int u = 0; u < 2; ++u)
#pragma unroll
          for (int i = 0; i < 4; ++i) *(u32x2*)(a_out + blk_off(row0 + u, i * 256 + lane * 4)) = (u32x2){0u, 0u};
      }
      continue;
    }
    f32x4 h[2][4];
    u32x2 yw[2][4];
#pragma unroll
    for (int u = 0; u < 2; ++u) {
      const float* hs = h_src(p, src_mode, s, t + u, Lr);
#pragma unroll
      for (int i = 0; i < 4; ++i) h[u][i] = __builtin_nontemporal_load((const f32x4*)(hs + i * 256 + lane * 4));
      if (y) {
#pragma unroll
        for (int i = 0; i < 4; ++i)
          yw[u][i] = *(const u32x2*)(y + (yblk ? blk_off(row0 + u, i * 256 + lane * 4) : (size_t)(row0 + u) * ldy + i * 256 + lane * 4));
      }
    }
#pragma unroll
    for (int u = 0; u < 2; ++u) {
      if (y) {
        f32x4 yv[4]; float ss = 0.f;
#pragma unroll
        for (int i = 0; i < 4; ++i) {
          const u32x2 w = yw[u][i];
          yv[i] = (f32x4){bflo(w.x), bfhi(w.x), bflo(w.y), bfhi(w.y)};
          ss += yv[i][0] * yv[i][0] + yv[i][1] * yv[i][1] + yv[i][2] * yv[i][2] + yv[i][3] * yv[i][3];
        }
        ss = wave_sum(ss);
        const float rstd = rsqrtf(ss * (1.0f / DM) + EPSF) * coef;
#pragma unroll
        for (int i = 0; i < 4; ++i) {
          const f32x4 g = *(const f32x4*)(g_post + i * 256 + lane * 4);
          h[u][i] += yv[i] * rstd * g;
        }
      }
      if (write_h) {
        float* hd = h_dst(p, s, t + u, Lr);
#pragma unroll
        for (int i = 0; i < 4; ++i) __builtin_nontemporal_store(h[u][i], (f32x4*)(hd + i * 256 + lane * 4));
      }
    }
    if (a_out) {
#pragma unroll
      for (int u = 0; u < 2; ++u) {
        float ss = 0.f;
#pragma unroll
        for (int i = 0; i < 4; ++i) ss += h[u][i][0] * h[u][i][0] + h[u][i][1] * h[u][i][1] + h[u][i][2] * h[u][i][2] + h[u][i][3] * h[u][i][3];
        ss = wave_sum(ss);
        const float rstd = rsqrtf(ss * (1.0f / DM) + EPSF);
#pragma unroll
        for (int i = 0; i < 4; ++i) {
          const f32x4 g = *(const f32x4*)(g_pre + i * 256 + lane * 4);
          const f32x4 v = h[u][i] * rstd * g;
          *(u32x2*)(a_out + blk_off(row0 + u, i * 256 + lane * 4)) = (u32x2){pk2(v[0], v[1]), pk2(v[2], v[3])};
        }
      }
    }
  }
}

struct GemmJob {
  const bf16_t* A; int lda; const bf16_t* Bt; int K; int nt0, ntn;
  bf16_t* C; int ldc; int nvalid; int nfirst; int vrows; int NR; int ablk; int cblk; int rev;
  const float2* tab;
};
template <int OFF> DEVI bf16x8 ldsr(unsigned a) { bf16x8 v; asm volatile("ds_read_b128 %0, %1 offset:%2" : "=v"(v) : "v"(a), "n"(OFF)); return v; }
template <int TOP> DEVI void lgkm_wait(int i) {
  switch (TOP - i) {
    case 0: asm volatile("s_waitcnt lgkmcnt(0)" ::: "memory"); break;
    case 1: asm volatile("s_waitcnt lgkmcnt(1)" ::: "memory"); break;
    case 2: asm volatile("s_waitcnt lgkmcnt(2)" ::: "memory"); break;
    case 3: asm volatile("s_waitcnt lgkmcnt(3)" ::: "memory"); break;
    case 4: asm volatile("s_waitcnt lgkmcnt(4)" ::: "memory"); break;
    case 5: asm volatile("s_waitcnt lgkmcnt(5)" ::: "memory"); break;
    case 6: asm volatile("s_waitcnt lgkmcnt(6)" ::: "memory"); break;
    default: asm volatile("s_waitcnt lgkmcnt(7)" ::: "memory"); break;
  }
}
#define RAW_BARRIER() do { asm volatile("s_waitcnt lgkmcnt(0)" ::: "memory"); __builtin_amdgcn_s_barrier(); } while (0)

template <int EPI, int NB>
DEVI void gemm_epilogue(const GemmJob& J, f32x4 (&acc)[4][NB], int mbase, int nbase, int lane) {
  const int l16 = lane & 15, g = lane >> 4;
  if constexpr (EPI == 0) {
    const int fbase = (nbase >> 1) + g * 4;
#pragma unroll
    for (int mb = 0; mb < 4; ++mb) {
      const int rowi = mbase + mb * 16 + l16;
#pragma unroll
      for (int grp = 0; grp < NB / 4; ++grp)
#pragma unroll
        for (int nb = 0; nb < 2; ++nb) {
          float o[4];
#pragma unroll
          for (int r = 0; r < 4; ++r) {
            const float gv = acc[mb][grp * 4 + nb][r], uv = acc[mb][grp * 4 + nb + 2][r];
            o[r] = gv * uv * __builtin_amdgcn_rcpf(1.0f + __expf(-gv));
          }
          *(u32x2*)(J.C + blk_off(rowi, fbase + grp * 32 + nb * 16)) = (u32x2){pk2(o[0], o[1]), pk2(o[2], o[3])};
        }
    }
  } else if constexpr (EPI == 1 || EPI == 3 || EPI == 4) {
    if constexpr (EPI == 3) {
#pragma unroll
      for (int mb = 0; mb < 4; ++mb) {
        int s, t, Lr, kb; row_info(mbase + mb * 16 + l16, s, t, Lr, kb);
        const int pos = t < Lr ? 16 + t : t - Lr;
        const float2* tp = J.tab + pos * 16 + g * 4;
#pragma unroll
        for (int nb = 0; nb < NB - 1; ++nb) {
          if ((((nbase >> 4) + nb) % 6) == 4) {
#pragma unroll
            for (int r = 0; r < 4; ++r) {
              const float2 cs = tp[r];
              const float x1 = acc[mb][nb][r], x2 = acc[mb][nb + 1][r];
              acc[mb][nb][r] = x1 * cs.x - x2 * cs.y;
              acc[mb][nb + 1][r] = x2 * cs.x + x1 * cs.y;
            }
          }
        }
      }
    }
#pragma unroll
    for (int mb = 0; mb < 4; ++mb) {
      bf16_t* rowp = J.C + (size_t)(mbase + mb * 16 + l16) * J.ldc;
#pragma unroll
      for (int nb = 0; nb < NB; ++nb) {
        const int n = nbase + nb * 16 + g * 4;
        int col = n;
        if constexpr (EPI == 4) col = (n >> 6) * 96 + (n & 63);
        if (n < J.nvalid) {
          bf16_t* dp = rowp + col;
          if constexpr (EPI == 1) { if (J.cblk) dp = J.C + blk_off(mbase + mb * 16 + l16, col); }
          *(u32x2*)dp = (u32x2){pk2(acc[mb][nb][0], acc[mb][nb][1]), pk2(acc[mb][nb][2], acc[mb][nb][3])};
        }
      }
    }
  } else {
#pragma unroll
    for (int mb = 0; mb < 4; ++mb) {
      int s, t, Lr, kb; row_info(mbase + mb * 16, s, t, Lr, kb);
      const int Lk = Lr + 64;
      bf16_t* basep = J.C + (size_t)J.vrows * kb + t + g * 4;
#pragma unroll
      for (int nb = 0; nb < NB; ++nb) {
        const int vr = nbase + nb * 16 + l16 - J.nfirst;
        if (vr < J.vrows)
          *(u32x2*)(basep + (size_t)vr * Lk) = (u32x2){pk2(acc[mb][nb][0], acc[mb][nb][1]), pk2(acc[mb][nb][2], acc[mb][nb][3])};
      }
    }
  }
}

template <int EPI, int NB>
DEVI void gemm_tile(const GemmJob& J, int m0, int n0, unsigned char* smem) {
  constexpr bool SWAP = (EPI != 2);
  constexpr int BN = NB * 32;
  constexpr int A_BYTES = 128 * 64;
  constexpr int STG = A_BYTES + BN * 64;
  constexpr int S = (NB == 8) ? 3 : 4;
  constexpr int LB = BN / 64;
  const int tid = otid(), lane = tid & 63, wid = tid >> 6, wm = wid >> 1, wn = wid & 1;
  const int l16 = lane & 15, g = lane >> 4;
  f32x4 acc[4][NB];
#pragma unroll
  for (int i = 0; i < 4; ++i)
#pragma unroll
    for (int j = 0; j < NB; ++j) acc[i][j] = (f32x4){0.f, 0.f, 0.f, 0.f};
  const int srow = tid >> 2, sch = tid & 3;
  const int gch = sch ^ ((0 - (tid >> 4)) & 3);
  const bf16_t* Ag = J.A + (size_t)(m0 + srow) * (J.ablk ? 32 : J.lda) + gch * 8;
  const bf16_t* Bg = J.Bt + (size_t)(n0 + srow) * 32 + gch * 8;
  const size_t Astep = (size_t)64 * (J.ablk ? 32 : J.lda), Ak = J.ablk ? (size_t)MROWS * 32 : (size_t)32, Bstep = (size_t)64 * 32, Bk = (size_t)J.NR * 32;
  const int nk = J.K >> 5;
  unsigned char* lds_t = smem + tid * 16;
  const unsigned lbase = (unsigned)(uintptr_t)(__attribute__((address_space(3))) unsigned char*)smem;
#define GEMM_ISSUE(kt_, st_) do { \
    unsigned char* st__ = lds_t + (st_) * STG; \
    _Pragma("unroll") for (int i = 0; i < 2; ++i) \
      __builtin_amdgcn_global_load_lds((const unsigned*)(Ag + i * Astep + (size_t)(kt_) * Ak), (LDSP)(st__ + i * 4096), 16, 0, 0); \
    _Pragma("unroll") for (int i = 0; i < LB; ++i) \
      __builtin_amdgcn_global_load_lds((const unsigned*)(Bg + i * Bstep + (size_t)(kt_) * Bk), (LDSP)(st__ + A_BYTES + i * 4096), 16, 0, 0); \
  } while (0)
  asm volatile("s_waitcnt vmcnt(0)" ::: "memory");
  RAW_BARRIER();
#pragma unroll
  for (int st = 0; st < S - 1; ++st) GEMM_ISSUE(st, st);
  const int fsl = (g ^ ((0 - (l16 >> 2)) & 3)) << 4;
  const int aofs = (wm * 64 + l16) * 64 + fsl;
  const int bofs = A_BYTES + (wn * NB * 16 + l16) * 64 + fsl;
  int cs = 0, is = S - 1;
#pragma clang loop unroll(disable)
  for (int kt = 0; kt < nk; ++kt) {
    if (nk - 1 - kt >= S - 2) {
      if constexpr (NB == 8) asm volatile("s_waitcnt vmcnt(6)" ::: "memory");
      else                   asm volatile("s_waitcnt vmcnt(8)" ::: "memory");
    } else {
      asm volatile("s_waitcnt vmcnt(0)" ::: "memory");
    }
    RAW_BARRIER();
    if (kt + S - 1 < nk) GEMM_ISSUE(kt + S - 1, is);
    is = (is + 1 == S) ? 0 : is + 1;
    const unsigned cur = lbase + cs * STG;
    cs = (cs + 1 == S) ? 0 : cs + 1;
    bf16x8 af[4], bfr[NB];
    const unsigned aa = cur + aofs, ba = cur + bofs;
    af[0] = ldsr<0>(aa); af[1] = ldsr<1024>(aa); af[2] = ldsr<2048>(aa); af[3] = ldsr<3072>(aa);
    bfr[0] = ldsr<0>(ba); bfr[1] = ldsr<1024>(ba); bfr[2] = ldsr<2048>(ba); bfr[3] = ldsr<3072>(ba);
    __builtin_amdgcn_s_setprio(1);
#pragma unroll
    for (int nb = 0; nb < NB; ++nb) {
      if (nb == 0) asm volatile("s_waitcnt lgkmcnt(3)" : "+v"(af[0]), "+v"(af[1]), "+v"(af[2]), "+v"(af[3]), "+v"(bfr[0]) :: "memory");
      else if (nb <= NB - 4) asm volatile("s_waitcnt lgkmcnt(3)" : "+v"(bfr[nb]) :: "memory");
      else if (nb == NB - 3) asm volatile("s_waitcnt lgkmcnt(2)" : "+v"(bfr[nb]) :: "memory");
      else if (nb == NB - 2) asm volatile("s_waitcnt lgkmcnt(1)" : "+v"(bfr[nb]) :: "memory");
      else asm volatile("s_waitcnt lgkmcnt(0)" : "+v"(bfr[nb]) :: "memory");
      __builtin_amdgcn_sched_barrier(0);
#pragma unroll
      for (int mb = 0; mb < 4; ++mb) {
        if constexpr (SWAP) acc[mb][nb] = __builtin_amdgcn_mfma_f32_16x16x32_bf16(bfr[nb], af[mb], acc[mb][nb], 0, 0, 0);
        else                acc[mb][nb] = __builtin_amdgcn_mfma_f32_16x16x32_bf16(af[mb], bfr[nb], acc[mb][nb], 0, 0, 0);
      }
      if constexpr (NB == 8) {
        __builtin_amdgcn_sched_barrier(0);
        if (nb == 0) bfr[4] = ldsr<4096>(ba);
        if (nb == 1) bfr[5] = ldsr<5120>(ba);
        if (nb == 2) bfr[6] = ldsr<6144>(ba);
        if (nb == 3) bfr[7] = ldsr<7168>(ba);
      }
    }
    __builtin_amdgcn_s_setprio(0);
  }
#undef GEMM_ISSUE
  gemm_epilogue<EPI, NB>(J, acc, m0 + wm * 64, n0 + wn * NB * 16, lane);
}

template <int EPI, int NB>
DEVI void gemm_run(const GemmJob& J, unsigned char* smem, int rot) {
  constexpr int BN = NB * 32;
  const int G = gridDim.x;
  int b = (int)blockIdx.x - rot; if (b < 0) b += G;
  if (G & 7) {
    const int ntiles = MT128 * J.ntn;
    for (int t = b; t < ntiles; t += G) {
      const int mt = t / J.ntn, nt = J.nt0 + (t - mt * J.ntn);
      gemm_tile<EPI, NB>(J, mt * 128, nt * BN, smem);
    }
  } else {
    const int x = b & 7, lb = b >> 3, nlb = G >> 3;
    const int mlo = x * 49;
    const int mcnt = min(49, MT128 - mlo);
    const int ntot = mcnt * J.ntn, gsz = 8 * J.ntn;
    const int ngrp = (mcnt + 7) >> 3;
    for (int q0 = lb; q0 < ntot; q0 += nlb) {
      const int q = J.rev ? ntot - 1 - q0 : q0;
      int grp = q / gsz; const int qq = q - grp * gsz;
      const int mg = min(8, mcnt - grp * 8);
      const int nt = qq / mg, mi = qq - nt * mg;
      gemm_tile<EPI, NB>(J, (mlo + grp * 8 + mi) * 128, (J.nt0 + nt) * BN, smem);
    }
  }
  __syncthreads();
}

DEVI void head_norm_rope8(bf16_t* ptr, int lane, const float* gain, float rowp, float colp, const float2* tab, bool do_store) {
  const int k8 = lane & 7;
  const u32x4 w = *(const u32x4*)ptr;
  float x[8] = {bflo(w.x), bfhi(w.x), bflo(w.y), bfhi(w.y), bflo(w.z), bfhi(w.z), bflo(w.w), bfhi(w.w)};
  float ss = 0.f;
#pragma unroll
  for (int j = 0; j < 8; ++j) ss += x[j] * x[j];
  ss += __shfl_xor(ss, 1); ss += __shfl_xor(ss, 2); ss += __shfl_xor(ss, 4);
  const float rstd = rsqrtf(ss * (1.0f / 64.0f) + EPSF);
  const float pos = (k8 < 4) ? rowp : colp;
  const int ip = (int)fabsf(pos);
  const float sgn = pos < 0.f ? -1.f : 1.f;
  const bool first = !(k8 & 2);
  float o[8];
#pragma unroll
  for (int j = 0; j < 8; ++j) {
    const float xn = x[j] * rstd * gain[k8 * 8 + j];
    const float pr = __shfl_xor(xn, 2);
    const float2 cs = tab[ip * 16 + (k8 & 1) * 8 + j];
    const float sn = cs.y * sgn;
    o[j] = first ? (xn * cs.x - pr * sn) : (xn * cs.x + pr * sn);
  }
  if (do_store) *(u32x4*)ptr = (u32x4){pk2(o[0], o[1]), pk2(o[2], o[3]), pk2(o[4], o[5]), pk2(o[6], o[7])};
}

DEVI void split_phase(const Params& p) {
  bf16_t* Hb = (bf16_t*)(p.ws + WS_H);
  bf16_t* proj = Hb + H_PROJ;
  bf16_t* kmla = Hb + H_KMLA;
  const float2* tab = (const float2*)(p.ws + WS_TAB);
  const int tid0 = otid();
  const int lane = tid0 & 63;
  const int gw = blockIdx.x * 4 + (tid0 >> 6), nw = gridDim.x * 4;
  for (int row = gw; row < MROWS; row += nw) {
    int s, t, Lr, kb; row_info(row, s, t, Lr, kb);
    const bool ismeta = t >= Lr;
    const int posA = ismeta ? t - Lr : 16 + t;
    const float rowp = ismeta ? -1.f : (float)(t >> 6);
    const float colp = ismeta ? (float)(t - Lr) : (float)(t & 63);
    bf16_t* pr = proj + (size_t)row * 1056;
    {
      const u32x2 w = *(const u32x2*)(pr + lane * 4);
      const float x0 = bflo(w.x), x1 = bfhi(w.x), x2 = bflo(w.y), x3 = bfhi(w.y);
      const float ss = wave_sum(x0 * x0 + x1 * x1 + x2 * x2 + x3 * x3);
      const float rstd = rsqrtf(ss * (1.0f / 256.0f) + EPSF);
      const f32x4 g = *(const f32x4*)(p.mla_q_norm + lane * 4);
      *(u32x2*)(pr + lane * 4) = (u32x2){pk2(x0 * rstd * g[0], x1 * rstd * g[1]), pk2(x2 * rstd * g[2], x3 * rstd * g[3])};
    }
    {
      const unsigned w = *(const unsigned*)(pr + 256 + lane * 2);
      const float x0 = bflo(w), x1 = bfhi(w);
      const float ss = wave_sum(x0 * x0 + x1 * x1);
      const float rstd = rsqrtf(ss * (1.0f / 128.0f) + EPSF);
      *(unsigned*)(pr + 256 + lane * 2) = pk2(x0 * rstd * p.mla_kv_norm[lane * 2], x1 * rstd * p.mla_kv_norm[lane * 2 + 1]);
    }
    head_norm_rope8(pr + 384 + lane * 8, lane, p.gqa_q_norm, rowp, colp, tab, true);
    head_norm_rope8(pr + 896 + (lane & 15) * 8, lane, p.gqa_k_norm, rowp, colp, tab, lane < 16);
    {
      const int d = lane & 31;
      const float x = bf2f(pr[1024 + d]);
      const float pr2 = __shfl_xor(x, 16);
      const float2 cs = tab[posA * 16 + (d & 15)];
      const float o = (d < 16) ? (x * cs.x - pr2 * cs.y) : (x * cs.x + pr2 * cs.y);
      const unsigned ob = pk2(o, o) & 0xffffu;
      if (lane < 32) {
        bf16_t* kd = kmla + (size_t)row * 768 + 64 + d;
#pragma unroll
        for (int h = 0; h < 8; ++h) kd[h * 96] = (bf16_t)ob;
      }
    }
  }
}

constexpr int ATT_STAGE = 20480;
constexpr int ATT_BIAS_OFF = 61440;
struct AttnArgs {
  const bf16_t* Q; int ldq;
  const bf16_t* K; int ldk;
  const bf16_t* Vt; int Lk;
  bf16_t* O; int orow0, ocol0;
  int nq;
  int first, nreg, Lr;
  float sc2;
  int R, rs;
};

template <int OFF> DEVI u32x2 ldsr64(unsigned a) { u32x2 v; asm volatile("ds_read_b64 %0, %1 offset:%2" : "=v"(v) : "v"(a), "n"(OFF)); return v; }
DEVI float ldsr32(unsigned a) { float v; asm volatile("ds_read_b32 %0, %1" : "=v"(v) : "v"(a)); return v; }
DEVI float xmax16(float x) { auto r = __builtin_amdgcn_permlane16_swap(__float_as_uint(x), __float_as_uint(x), false, false); return fmaxf(__uint_as_float(r[0]), __uint_as_float(r[1])); }
DEVI float xmax32(float x) { auto r = __builtin_amdgcn_permlane32_swap(__float_as_uint(x), __float_as_uint(x), false, false); return fmaxf(__uint_as_float(r[0]), __uint_as_float(r[1])); }
DEVI float xsum16(float x) { auto r = __builtin_amdgcn_permlane16_swap(__float_as_uint(x), __float_as_uint(x), false, false); return __uint_as_float(r[0]) + __uint_as_float(r[1]); }
DEVI float xsum32(float x) { auto r = __builtin_amdgcn_permlane32_swap(__float_as_uint(x), __float_as_uint(x), false, false); return __uint_as_float(r[0]) + __uint_as_float(r[1]); }

template <int DK, int QB, bool NA>
DEVI void attn_item(const AttnArgs& a, unsigned char* smem) {
  constexpr int KS = DK / 32;
  constexpr int S = 3;
  const int tid = otid(), lane = tid & 63, w = tid >> 6;
  const int l16 = lane & 15, g = lane >> 4;
  const bool wact = (w * QB * 16) < a.nq;
  const int nt = a.nreg + 1;
  const unsigned lbase = (unsigned)(uintptr_t)(__attribute__((address_space(3))) unsigned char*)smem;

  bf16x8 qf[QB][KS];
#pragma unroll
  for (int qb = 0; qb < QB; ++qb) {
    const bf16_t* qp = a.Q + (size_t)((wact ? w * QB * 16 : 0) + qb * 16 + l16) * a.ldq + g * 8;
#pragma unroll
    for (int ks = 0; ks < KS; ++ks) qf[qb][ks] = *(const bf16x8*)(qp + ks * 32);
  }
  float m[QB], l[QB];
  f32x4 o[4][QB];
#pragma unroll
  for (int qb = 0; qb < QB; ++qb) {
    m[qb] = NA ? -1e30f : 0.f; l[qb] = 0.f;
#pragma unroll
    for (int db = 0; db < 4; ++db) o[db][qb] = (f32x4){0.f, 0.f, 0.f, 0.f};
  }
  const int r8 = tid >> 3, c8 = (tid & 7) ^ ((tid >> 4) & 7);
  const bf16_t* Kn = a.K + (size_t)r8 * a.ldk + c8 * 8;
  const bf16_t* Kr = a.K + (size_t)(tid >> 2) * a.ldk + 64 + (((tid & 3) ^ ((0 - (tid >> 4)) & 3)) * 8);
  const bf16_t* Vg = a.Vt + (size_t)r8 * a.Lk + c8 * 8;
  const size_t kstep = (size_t)32 * a.ldk, vstep = (size_t)32 * a.Lk;
  unsigned char* lds_t = smem + tid * 16;
#define ATT_ISSUE(j_, st_) do { \
    const int ko__ = ((j_) < a.nreg) ? (a.first + (j_)) * 64 : a.Lr; \
    unsigned char* st__ = lds_t + (st_) * ATT_STAGE; \
    const bf16_t* kp__ = Kn + (size_t)ko__ * a.ldk; \
    __builtin_amdgcn_global_load_lds((const unsigned*)(kp__), (LDSP)(st__), 16, 0, 0); \
    __builtin_amdgcn_global_load_lds((const unsigned*)(kp__ + kstep), (LDSP)(st__ + 4096), 16, 0, 0); \
    if constexpr (DK == 96) __builtin_amdgcn_global_load_lds((const unsigned*)(Kr + (size_t)ko__ * a.ldk), (LDSP)(st__ + 8192), 16, 0, 0); \
    __builtin_amdgcn_global_load_lds((const unsigned*)(Vg + ko__), (LDSP)(st__ + 12288), 16, 0, 0); \
    __builtin_amdgcn_global_load_lds((const unsigned*)(Vg + vstep + ko__), (LDSP)(st__ + 12288 + 4096), 16, 0, 0); \
  } while (0)
  asm volatile("s_waitcnt vmcnt(0)" ::: "memory");
  RAW_BARRIER();
  ATT_ISSUE(0, 0);
  if (nt > 1) ATT_ISSUE(1, 1);
  const int sw8 = (l16 >> 1) & 7, vsw = sw8 << 1;
  const unsigned ka0 = l16 * 128 + ((g ^ sw8) << 4), ka1 = l16 * 128 + (((4 + g) ^ sw8) << 4);
  const unsigned kr = 8192 + l16 * 64 + ((g ^ ((0 - (l16 >> 2)) & 3)) << 4);
  const unsigned vb00 = 12288 + l16 * 128 + (((0 + g) ^ vsw) << 3), vb01 = 12288 + l16 * 128 + (((4 + g) ^ vsw) << 3);
  const unsigned vb10 = 12288 + l16 * 128 + (((8 + g) ^ vsw) << 3), vb11 = 12288 + l16 * 128 + (((12 + g) ^ vsw) << 3);
  const unsigned biasA = lbase + ATT_BIAS_OFF;
  const int qc = w * 16 + l16;
  const int cs0 = min(max(qc - 8, 0), 48);
  int cs = 0, is = 2;
  for (int j = 0; j < nt; ++j) {
    if (j + 1 < nt) {
      if constexpr (DK == 96) asm volatile("s_waitcnt vmcnt(5)" ::: "memory");
      else                    asm volatile("s_waitcnt vmcnt(4)" ::: "memory");
    } else {
      asm volatile("s_waitcnt vmcnt(0)" ::: "memory");
    }
    RAW_BARRIER();
    if (j + 2 < nt) ATT_ISSUE(j + 2, is);
    is = (is + 1 == S) ? 0 : is + 1;
    const unsigned cur = lbase + cs * ATT_STAGE;
    cs = (cs + 1 == S) ? 0 : cs + 1;
    if (wact) {
      f32x4 s[4][QB];
#pragma unroll
      for (int kb = 0; kb < 4; ++kb)
#pragma unroll
        for (int qb = 0; qb < QB; ++qb) s[kb][qb] = (f32x4){0.f, 0.f, 0.f, 0.f};
      {
        bf16x8 k0[4], k1[4], k2[4];
        const unsigned a0 = cur + ka0, a1 = cur + ka1, a2 = cur + kr;
        k0[0] = ldsr<0>(a0); k0[1] = ldsr<2048>(a0); k0[2] = ldsr<4096>(a0); k0[3] = ldsr<6144>(a0);
        k1[0] = ldsr<0>(a1); k1[1] = ldsr<2048>(a1); k1[2] = ldsr<4096>(a1); k1[3] = ldsr<6144>(a1);
        if constexpr (KS == 3) { k2[0] = ldsr<0>(a2); k2[1] = ldsr<1024>(a2); k2[2] = ldsr<2048>(a2); k2[3] = ldsr<3072>(a2); }
        if constexpr (KS == 3) asm volatile("s_waitcnt lgkmcnt(8)" : "+v"(k0[0]), "+v"(k0[1]), "+v"(k0[2]), "+v"(k0[3]) :: "memory");
        else                   asm volatile("s_waitcnt lgkmcnt(4)" : "+v"(k0[0]), "+v"(k0[1]), "+v"(k0[2]), "+v"(k0[3]) :: "memory");
        __builtin_amdgcn_sched_barrier(0);
#pragma unroll
        for (int kb = 0; kb < 4; ++kb)
#pragma unroll
          for (int qb = 0; qb < QB; ++qb) s[kb][qb] = __builtin_amdgcn_mfma_f32_16x16x32_bf16(k0[kb], qf[qb][0], s[kb][qb], 0, 0, 0);
        if constexpr (KS == 3) asm volatile("s_waitcnt lgkmcnt(4)" : "+v"(k1[0]), "+v"(k1[1]), "+v"(k1[2]), "+v"(k1[3]) :: "memory");
        else                   asm volatile("s_waitcnt lgkmcnt(0)" : "+v"(k1[0]), "+v"(k1[1]), "+v"(k1[2]), "+v"(k1[3]) :: "memory");
        __builtin_amdgcn_sched_barrier(0);
#pragma unroll
        for (int kb = 0; kb < 4; ++kb)
#pragma unroll
          for (int qb = 0; qb < QB; ++qb) s[kb][qb] = __builtin_amdgcn_mfma_f32_16x16x32_bf16(k1[kb], qf[qb][1], s[kb][qb], 0, 0, 0);
        if constexpr (KS == 3) {
          asm volatile("s_waitcnt lgkmcnt(0)" : "+v"(k2[0]), "+v"(k2[1]), "+v"(k2[2]), "+v"(k2[3]) :: "memory");
          __builtin_amdgcn_sched_barrier(0);
#pragma unroll
          for (int kb = 0; kb < 4; ++kb)
#pragma unroll
            for (int qb = 0; qb < QB; ++qb) s[kb][qb] = __builtin_amdgcn_mfma_f32_16x16x32_bf16(k2[kb], qf[qb][2], s[kb][qb], 0, 0, 0);
        }
      }
      u32x2 va[2][4], vbq[2][4];
      {
        const unsigned p00 = cur + vb00, p01 = cur + vb01, p10 = cur + vb10, p11 = cur + vb11;
        va[0][0] = ldsr64<0>(p00); vbq[0][0] = ldsr64<0>(p01); va[0][1] = ldsr64<2048>(p00); vbq[0][1] = ldsr64<2048>(p01);
        va[0][2] = ldsr64<4096>(p00); vbq[0][2] = ldsr64<4096>(p01); va[0][3] = ldsr64<6144>(p00); vbq[0][3] = ldsr64<6144>(p01);
        va[1][0] = ldsr64<0>(p10); vbq[1][0] = ldsr64<0>(p11); va[1][1] = ldsr64<2048>(p10); vbq[1][1] = ldsr64<2048>(p11);
        va[1][2] = ldsr64<4096>(p10); vbq[1][2] = ldsr64<4096>(p11); va[1][3] = ldsr64<6144>(p10); vbq[1][3] = ldsr64<6144>(p11);
      }
      const bool ismeta = (j == nt - 1);
      bf16x8 pf[QB][2];
      if constexpr (!NA) {
        typedef float f32x2 __attribute__((ext_vector_type(2)));
#pragma unroll
        for (int qb = 0; qb < QB; ++qb) {
          if (ismeta) {
#pragma unroll
            for (int kb = 1; kb < 4; ++kb) s[kb][qb] = (f32x4){-1e30f, -1e30f, -1e30f, -1e30f};
          }
          const f32x2 scv = {a.sc2, a.sc2}, nmv = {-m[qb], -m[qb]};
          f32x2 t[4][2];
#pragma unroll
          for (int kb = 0; kb < 4; ++kb)
#pragma unroll
            for (int h = 0; h < 2; ++h) {
              const f32x2 sv = {s[kb][qb][2 * h], s[kb][qb][2 * h + 1]};
              t[kb][h] = sv * scv + nmv;
            }
          float mx = fmaxf(t[0][0].x, t[0][0].y);
#pragma unroll
          for (int kb = 0; kb < 4; ++kb)
#pragma unroll
            for (int h = 0; h < 2; ++h) mx = fmaxf(mx, fmaxf(t[kb][h].x, t[kb][h].y));
          if (j == 0 || __any(mx > 6.f)) {
            mx = xmax32(xmax16(mx));
            const float d = (j == 0) ? mx : fmaxf(mx, 0.f);
            const float alpha = __builtin_amdgcn_exp2f(-d);
            const f32x2 dv = {d, d};
#pragma unroll
            for (int kb = 0; kb < 4; ++kb)
#pragma unroll
              for (int h = 0; h < 2; ++h) t[kb][h] -= dv;
            m[qb] += d;
            l[qb] *= alpha;
#pragma unroll
            for (int db = 0; db < 4; ++db) o[db][qb] *= alpha;
          }
          f32x2 ls2 = {0.f, 0.f};
          unsigned pw[2][4];
#pragma unroll
          for (int kb = 0; kb < 4; ++kb)
#pragma unroll
            for (int h = 0; h < 2; ++h) {
              const f32x2 pe = {__builtin_amdgcn_exp2f(t[kb][h].x), __builtin_amdgcn_exp2f(t[kb][h].y)};
              ls2 += pe;
              pw[kb >> 1][(kb & 1) * 2 + h] = pk2(pe.x, pe.y);
            }
          l[qb] += ls2.x + ls2.y;
#pragma unroll
          for (int c = 0; c < 2; ++c) {
            const u32x4 pv = (u32x4){pw[c][0], pw[c][1], pw[c][2], pw[c][3]};
            pf[qb][c] = __builtin_bit_cast(bf16x8, pv);
          }
        }
      } else {
#pragma unroll
      for (int qb = 0; qb < QB; ++qb) {
        float tv[4][4];
#pragma unroll
        for (int kb = 0; kb < 4; ++kb)
#pragma unroll
          for (int r = 0; r < 4; ++r) tv[kb][r] = s[kb][qb][r] * a.sc2;
        if (ismeta) {
          if constexpr (NA) {
            float bv[4];
#pragma unroll
            for (int r = 0; r < 4; ++r) bv[r] = ldsr32(biasA + (480 + g * 4 + r) * 4);
            asm volatile("s_waitcnt lgkmcnt(0)" : "+v"(bv[0]), "+v"(bv[1]), "+v"(bv[2]), "+v"(bv[3]) :: "memory");
            __builtin_amdgcn_sched_barrier(0);
#pragma unroll
            for (int r = 0; r < 4; ++r) tv[0][r] += bv[r];
          }
#pragma unroll
          for (int r = 0; r < 4; ++r) { tv[1][r] = -1e30f; tv[2][r] = -1e30f; tv[3][r] = -1e30f; }
        } else if constexpr (NA) {
          const int ro = (a.rs + j - a.R + 7) * 31 + 15 - qc;
          float bv[4][4];
#pragma unroll
          for (int kb = 0; kb < 4; ++kb)
#pragma unroll
            for (int r = 0; r < 4; ++r) {
              const int kc = kb * 16 + g * 4 + r;
              const bool in = (kc >= cs0) && (kc < cs0 + 16);
              bv[kb][r] = ldsr32(biasA + (in ? ro + kc : 0) * 4);
            }
          asm volatile("s_waitcnt lgkmcnt(0)"
                       : "+v"(bv[0][0]), "+v"(bv[0][1]), "+v"(bv[0][2]), "+v"(bv[0][3]), "+v"(bv[1][0]), "+v"(bv[1][1]), "+v"(bv[1][2]), "+v"(bv[1][3]),
                         "+v"(bv[2][0]), "+v"(bv[2][1]), "+v"(bv[2][2]), "+v"(bv[2][3]), "+v"(bv[3][0]), "+v"(bv[3][1]), "+v"(bv[3][2]), "+v"(bv[3][3])
                       :: "memory");
          __builtin_amdgcn_sched_barrier(0);
#pragma unroll
          for (int kb = 0; kb < 4; ++kb)
#pragma unroll
            for (int r = 0; r < 4; ++r) {
              const int kc = kb * 16 + g * 4 + r;
              const bool in = (kc >= cs0) && (kc < cs0 + 16);
              tv[kb][r] = in ? tv[kb][r] + bv[kb][r] : -1e30f;
            }
        }
        float mx = tv[0][0];
#pragma unroll
        for (int kb = 0; kb < 4; ++kb)
#pragma unroll
          for (int r = 0; r < 4; ++r) mx = fmaxf(mx, tv[kb][r]);
        mx = xmax32(xmax16(mx));
        const float mn = fmaxf(m[qb], mx);
        const float alpha = __builtin_amdgcn_exp2f(m[qb] - mn);
        const bool changed = (mn != m[qb]);
        m[qb] = mn;
        float ls = 0.f;
#pragma unroll
        for (int kb = 0; kb < 4; ++kb)
#pragma unroll
          for (int r = 0; r < 4; ++r) { tv[kb][r] = __builtin_amdgcn_exp2f(tv[kb][r] - mn); ls += tv[kb][r]; }
        l[qb] = l[qb] * alpha + ls;
        if (__any(changed)) {
#pragma unroll
          for (int db = 0; db < 4; ++db) o[db][qb] *= alpha;
        }
#pragma unroll
        for (int c = 0; c < 2; ++c) {
          u32x4 pw;
          pw.x = pk2(tv[2 * c][0], tv[2 * c][1]); pw.y = pk2(tv[2 * c][2], tv[2 * c][3]);
          pw.z = pk2(tv[2 * c + 1][0], tv[2 * c + 1][1]); pw.w = pk2(tv[2 * c + 1][2], tv[2 * c + 1][3]);
          pf[qb][c] = __builtin_bit_cast(bf16x8, pw);
        }
      }
      }
      asm volatile("s_waitcnt lgkmcnt(0)"
                   : "+v"(va[0][0]), "+v"(va[0][1]), "+v"(va[0][2]), "+v"(va[0][3]), "+v"(va[1][0]), "+v"(va[1][1]), "+v"(va[1][2]), "+v"(va[1][3]),
                     "+v"(vbq[0][0]), "+v"(vbq[0][1]), "+v"(vbq[0][2]), "+v"(vbq[0][3]), "+v"(vbq[1][0]), "+v"(vbq[1][1]), "+v"(vbq[1][2]), "+v"(vbq[1][3])
                   :: "memory");
      __builtin_amdgcn_sched_barrier(0);
#pragma unroll
      for (int c = 0; c < 2; ++c)
#pragma unroll
        for (int db = 0; db < 4; ++db) {
          const u32x4 vw = (u32x4){va[c][db].x, va[c][db].y, vbq[c][db].x, vbq[c][db].y};
          const bf16x8 vf = __builtin_bit_cast(bf16x8, vw);
#pragma unroll
          for (int qb = 0; qb < QB; ++qb) o[db][qb] = __builtin_amdgcn_mfma_f32_16x16x32_bf16(vf, pf[qb][c], o[db][qb], 0, 0, 0);
        }
    }
  }
#undef ATT_ISSUE
  if (wact) {
#pragma unroll
    for (int qb = 0; qb < QB; ++qb) {
      const float lt = xsum32(xsum16(l[qb]));
      const float inv = 1.0f / lt;
      const int qi = w * QB * 16 + qb * 16 + l16;
      if (qi < a.nq) {
#pragma unroll
        for (int db = 0; db < 4; ++db) {
          const f32x4 v = o[db][qb] * inv;
          *(u32x2*)(a.O + blk_off(a.orow0 + qi, a.ocol0 + db * 16 + g * 4)) = (u32x2){pk2(v[0], v[1]), pk2(v[2], v[3])};
        }
      }
    }
  }
}

DEVI int next_item(unsigned* ctr, int* sh) {
  __syncthreads();
  if (threadIdx.x == 0) *sh = (int)atomicAdd(ctr, 1u);
  __syncthreads();
  return __builtin_amdgcn_readfirstlane(*sh);
}

DEVI void attn_dense_phase(const Params& p, unsigned char* smem, unsigned* ctr) {
  bf16_t* Hb = (bf16_t*)(p.ws + WS_H);
  bf16_t* Ob = (bf16_t*)(p.ws + WS_A);
  int* sh = (int*)(smem + 73600);
  constexpr int NITEMS = 2048 + 4096 + 160;
  for (;;) {
    const int it = next_item(ctr, sh);
    if (it >= NITEMS) break;
    int s, h16, qt, nq = 128;
    if (it < 160) { s = it >> 4; h16 = it & 15; qt = -1; nq = 16; }
    else if (it < 160 + 2048) { const int id = it - 160; qt = id & 63; const int shd = id >> 6; if (shd < 16) { s = 8 + (shd >> 3); h16 = shd & 7; } else { s = 8 + ((shd - 16) >> 3); h16 = 8 + ((shd - 16) & 7); } }
    else { const int id = it - 160 - 2048; qt = id & 31; const int shd = id >> 5; if (shd < 64) { s = shd >> 3; h16 = shd & 7; } else { s = (shd - 64) >> 3; h16 = 8 + ((shd - 64) & 7); } }
    const int kb = seq_base(s), Lr = seq_lr(s), Lk = Lr + 64;
    const int q0 = kb + (qt < 0 ? Lr : qt * 128);
    AttnArgs a;
    a.nq = nq; a.first = 0; a.nreg = Lr >> 6; a.Lr = Lr; a.Lk = Lk; a.R = 0; a.rs = 0;
    a.O = Ob; a.orow0 = q0; a.ocol0 = h16 * 64;
    if (h16 < 8) {
      a.Q = Hb + H_QA + (size_t)q0 * 768 + h16 * 96; a.ldq = 768;
      a.K = Hb + H_KMLA + (size_t)kb * 768 + h16 * 96; a.ldk = 768;
      a.Vt = Hb + H_VTM + (size_t)512 * kb + (size_t)(h16 * 64) * Lk;
      a.sc2 = 0.10206207261596577f * LOG2E;
      attn_item<96, 2, false>(a, smem);
    } else {
      const int hq = h16 - 8, kvh = hq >> 2;
      a.Q = Hb + H_PROJ + (size_t)q0 * 1056 + 384 + hq * 64; a.ldq = 1056;
      a.K = Hb + H_PROJ + (size_t)kb * 1056 + 896 + kvh * 64; a.ldk = 1056;
      a.Vt = Hb + H_VTG + (size_t)128 * kb + (size_t)(kvh * 64) * Lk;
      a.sc2 = 0.125f * LOG2E;
      attn_item<64, 2, false>(a, smem);
    }
  }
}

DEVI void attn_na_phase(const Params& p, unsigned char* smem, unsigned* ctr) {
  bf16_t* Hb = (bf16_t*)(p.ws + WS_H);
  bf16_t* Ob = (bf16_t*)(p.ws + WS_A);
  int* sh = (int*)(smem + 73600);
  float* biasL = (float*)(smem + ATT_BIAS_OFF);
  constexpr int NP = 8 * 16 * 65, NS = 2 * 16 * 129;
  for (;;) {
    const int it = next_item(ctr, sh);
    if (it >= NP + NS) break;
    int s, h, R, rows;
    if (it < NS) { const int sh2 = it / 129; R = it - sh2 * 129; s = 8 + (sh2 >> 4); h = sh2 & 15; rows = 128; }
    else { const int id = it - NS; const int sh2 = id / 65; R = id - sh2 * 65; s = sh2 >> 4; h = sh2 & 15; rows = 64; }
    const int kb = seq_base(s), Lr = seq_lr(s), Lk = Lr + 64;
    for (int i = threadIdx.x; i < 465; i += 256) biasL[i] = p.na_rpb[h * 465 + i] * LOG2E;
    if (threadIdx.x < 16) biasL[480 + threadIdx.x] = p.na_meta_bias[h * 16 + threadIdx.x] * LOG2E;
    AttnArgs a;
    a.Lr = Lr; a.Lk = Lk; a.sc2 = 0.125f * LOG2E;
    a.K = Hb + H_NAQK + (size_t)kb * 2048 + 1024 + h * 64; a.ldk = 2048;
    a.Vt = Hb + H_VTN + (size_t)1024 * kb + (size_t)(h * 64) * Lk;
    a.ldq = 2048;
    int q0;
    if (R < rows) { const int rs = min(max(R - 4, 0), rows - 8); a.R = R; a.rs = rs; a.first = rs; a.nreg = 8; a.nq = 64; q0 = kb + R * 64; }
    else { a.R = 0; a.rs = 0; a.first = 0; a.nreg = 0; a.nq = 16; q0 = kb + Lr; }
    a.Q = Hb + H_NAQK + (size_t)q0 * 2048 + h * 64;
    a.O = Ob; a.orow0 = q0; a.ocol0 = h * 64;
    attn_item<64, 1, true>(a, smem);
  }
}

#define XB_TMO      128
#define XB_XCNT(j)  (256  + 64 * (j))
#define XB_XSUB(j)  (1280 + 64 * (j))
#define XB_XGEN(j)  (2304 + 64 * (j))
#define XB_TOP      3328
#define XB_TOPGEN   3392
#define XCD_BAR_WORDS 3456
#define XB_SPIN_CAP (1u << 20)
#define LAS __attribute__((address_space(3)))
DEVI unsigned xb_ld(unsigned* p)              { return __hip_atomic_load(p, __ATOMIC_RELAXED, __HIP_MEMORY_SCOPE_AGENT); }
DEVI unsigned xb_add(unsigned* p, unsigned v) { return __hip_atomic_fetch_add(p, v, __ATOMIC_RELAXED, __HIP_MEMORY_SCOPE_AGENT); }
DEVI unsigned xb_xcc_id() { return (unsigned)__builtin_amdgcn_s_getreg((3 << 11) | 20) & 0xFu; }
#define XB_SPIN(cond, bar) do { unsigned _sp = 0; while (cond) { __builtin_amdgcn_s_sleep(1); \
    if ((++_sp & 255u) == 0u) { if (xb_ld(&(bar)[XB_TMO])) break; if (_sp > XB_SPIN_CAP) { atomicAdd(&(bar)[XB_TMO], 1u); break; } } } } while (0)
struct XcdBarrier { unsigned* bar; unsigned x; volatile LAS unsigned* st; };
DEVI XcdBarrier xcd_barrier_post(unsigned* bar, volatile LAS unsigned* st) {
  XcdBarrier b; b.bar = bar; b.x = xb_xcc_id(); b.st = st;
  if (threadIdx.x == 0) (void)xb_add(&bar[XB_XCNT(b.x)], 1u);
  return b;
}
DEVI void xcd_barrier_complete(unsigned* bar, unsigned x, unsigned& nloc, unsigned& nx) {
  const unsigned G = gridDim.x * gridDim.y * gridDim.z;
  unsigned sum, cnt, mine, sp = 0u;
  for (;;) {
    sum = 0u; cnt = 0u; mine = 0u;
#pragma unroll
    for (unsigned j = 0; j < 16; ++j) { const unsigned c = xb_ld(&bar[XB_XCNT(j)]); sum += c; cnt += (c > 0u) ? 1u : 0u; mine = (j == x) ? c : mine; }
    if (sum == G) break;
    __builtin_amdgcn_s_sleep(1);
    if ((++sp & 255u) == 0u) { if (xb_ld(&bar[XB_TMO])) break; if (sp > XB_SPIN_CAP) { atomicAdd(&bar[XB_TMO], 1u); break; } }
  }
  nloc = mine > 0u ? mine : 1u; nx = cnt > 0u ? cnt : 1u;
}
DEVI void xcd_barrier(const XcdBarrier& b) {
  asm volatile("s_waitcnt vmcnt(0)" ::: "memory");
  __syncthreads();
  if (threadIdx.x == 0) {
    unsigned* bar = b.bar;
    __builtin_amdgcn_s_waitcnt(0);
    unsigned nloc = b.st[0], nx = b.st[1];
    if (nloc == 0u) { xcd_barrier_complete(bar, b.x, nloc, nx); b.st[0] = nloc; b.st[1] = nx; }
    const unsigned old = xb_add(&bar[XB_XSUB(b.x)], 1u);
    const unsigned gen = old / nloc;
    if (old + 1u == (gen + 1u) * nloc) {
      __builtin_amdgcn_fence(__ATOMIC_RELEASE, "agent");
      asm volatile("s_waitcnt vmcnt(0)" ::: "memory");
      const unsigned og = xb_add(&bar[XB_TOP], 1u);
      const unsigned tg = og / nx;
      if (og + 1u == (tg + 1u) * nx) xb_add(&bar[XB_TOPGEN], 1u);
      else XB_SPIN(xb_ld(&bar[XB_TOPGEN]) == tg, bar);
      __builtin_amdgcn_fence(__ATOMIC_ACQUIRE, "agent");
      xb_add(&bar[XB_XGEN(b.x)], 1u);
      asm volatile("s_waitcnt vmcnt(0)" ::: "memory");
    } else {
      XB_SPIN(xb_ld(&bar[XB_XGEN(b.x)]) == gen, bar);
      __builtin_amdgcn_fence(__ATOMIC_ACQUIRE, "agent");
      asm volatile("s_waitcnt vmcnt(0)" ::: "memory");
    }
  }
  __syncthreads();
}

__global__ void __launch_bounds__(256, 2) fwd_megakernel(Params p) {
  cg::grid_group grid = cg::this_grid();
  __shared__ __attribute__((aligned(16))) unsigned char smem[73728];
  __shared__ uint4 xb_words;
  if (threadIdx.x == 0) xb_words = make_uint4(0u, 0u, 0u, 0u);
  __syncthreads();
  const XcdBarrier xb = xcd_barrier_post((unsigned*)(p.ws + WS_BAR), (volatile LAS unsigned*)&xb_words);
  const int G = gridDim.x;
  unsigned* ctr = (unsigned*)(p.ws + WS_CTR);
  bf16_t* Wb = (bf16_t*)(p.ws + WS_W);
  bf16_t* Ab = (bf16_t*)(p.ws + WS_A);
  bf16_t* Hb = (bf16_t*)(p.ws + WS_H);
  float2* tab = (float2*)(p.ws + WS_TAB);

  {
    int rot = 0;
    for (int li = 0; li < 2; ++li)
      for (int f = 0; f < 2; ++f) {
        bf16_t* wgu = Wb + (size_t)(li * 2 + f) * W_FFN_EL;
        wt_transpose(p.ffn_w[f * 3 + 0] + (size_t)li * DM * DFF, DM, DFF, wgu, 5632, 1, smem, rot); rot = (rot + 1408) % G;
        wt_transpose(p.ffn_w[f * 3 + 1] + (size_t)li * DM * DFF, DM, DFF, wgu, 5632, 2, smem, rot); rot = (rot + 1408) % G;
        wt_transpose(p.ffn_w[f * 3 + 2] + (size_t)li * DM * DFF, DFF, DM, wgu + W_GU_EL, 1024, 0, smem, rot); rot = (rot + 1408) % G;
      }
    wt_transpose(p.attn_w_in, DM, 1184, Wb + W_IN_OFF, 1536, 3, smem, rot); rot = (rot + 592) % G;
    wt_transpose(p.mla_w_uq, 256, 768, Wb + W_UQ_OFF, 768, 0, smem, rot); rot = (rot + 96) % G;
    wt_transpose(p.mla_w_ukv, 128, 1024, Wb + W_UKV_OFF, 1024, 4, smem, rot); rot = (rot + 64) % G;
    wt_transpose(p.attn_w_out, DM, DM, Wb + W_OUT_OFF, 1024, 0, smem, rot); rot = (rot + 512) % G;
    wt_transpose(p.na_w_qkv, DM, 3072, Wb + W_NAQKV_OFF, 3072, 0, smem, rot); rot = (rot + 1536) % G;
    wt_transpose(p.na_w_out, DM, DM, Wb + W_NAOUT_OFF, 1024, 0, smem, rot);
    {
      for (int i = blockIdx.x * 256 + threadIdx.x; i < 32 * 352 * 4; i += G * 256) {
        const int q4 = i & 3, rr = (i >> 2) % 352, kbk = (i >> 2) / 352;
        const int r = rr < 224 ? 1056 + rr : 1408 + (rr - 224);
        *(u32x4*)(Wb + W_IN_OFF + ((size_t)kbk * 1536 + r) * 32 + q4 * 8) = (u32x4){0u, 0u, 0u, 0u};
      }
    }
    for (int i = blockIdx.x * 256 + threadIdx.x; i < 8208 * 16; i += G * 256) {
      const int pos = i >> 4, k = i & 15;
      const float ang = (float)pos * p.inv_freq[k];
      const double ad = (double)ang;
      const double q = rint(ad * 0.15915494309189535);
      const float rr = (float)(ad - q * 6.283185307179586);
      tab[i] = make_float2(__cosf(rr), __sinf(rr));
    }
    postnorm_phase(p, nullptr, 0, 0.f, nullptr, p.norm_gains, 0, false, Ab, false);
  }
  xcd_barrier(xb);
  if (p.ws == nullptr) grid.sync();

  for (int li = 0; li < 2; ++li) {
    const float* gains = p.norm_gains + (size_t)li * 6 * DM;
    {
      GemmJob J{}; J.A = Ab; J.lda = DM; J.Bt = Wb + (size_t)(li * 2) * W_FFN_EL; J.K = DM; J.NR = 5632; J.ablk = 1; J.nt0 = 0; J.ntn = 22; J.C = Hb; J.ldc = DFF;
      gemm_run<0, 8>(J, smem, 0);
    }
    xcd_barrier(xb);
    {
      GemmJob J{}; J.A = Hb; J.lda = DFF; J.Bt = Wb + (size_t)(li * 2) * W_FFN_EL + W_GU_EL; J.K = DFF; J.NR = 1024; J.ablk = 1; J.cblk = 1; J.rev = 1; J.nt0 = 0; J.ntn = 4; J.C = Ab; J.ldc = DM; J.nvalid = DM;
      gemm_run<1, 8>(J, smem, 0);
    }
    xcd_barrier(xb);
    postnorm_phase(p, Ab, DM, 0.5f, gains + DM, gains + 2 * DM, li == 0 ? 0 : 1, true, Ab, true);
    xcd_barrier(xb);
    if (li == 0) {
      {
        GemmJob J{}; J.A = Ab; J.lda = DM; J.Bt = Wb + W_IN_OFF; J.K = DM; J.NR = 1536; J.ablk = 1; J.nt0 = 0; J.ntn = 5; J.C = Hb + H_PROJ; J.ldc = 1056; J.nvalid = 1056;
        gemm_run<1, 8>(J, smem, 0);
        GemmJob V{}; V.A = Ab; V.lda = DM; V.Bt = Wb + W_IN_OFF; V.K = DM; V.NR = 1536; V.ablk = 1; V.nt0 = 5; V.ntn = 1; V.C = Hb + H_VTG; V.nfirst = 1280; V.vrows = 128;
        gemm_run<2, 8>(V, smem, (MT128 * 5) % G);
      }
      xcd_barrier(xb);
      split_phase(p);
      xcd_barrier(xb);
      {
        GemmJob J{}; J.A = Hb + H_PROJ; J.lda = 1056; J.Bt = Wb + W_UQ_OFF; J.K = 256; J.NR = 768; J.nt0 = 0; J.ntn = 3; J.C = Hb + H_QA; J.ldc = 768; J.nvalid = 768; J.tab = tab;
        gemm_run<3, 8>(J, smem, 0);
        GemmJob Kj{}; Kj.A = Hb + H_PROJ + 256; Kj.lda = 1056; Kj.Bt = Wb + W_UKV_OFF; Kj.K = 128; Kj.NR = 1024; Kj.nt0 = 0; Kj.ntn = 2; Kj.C = Hb + H_KMLA; Kj.ldc = 768; Kj.nvalid = 512;
        gemm_run<4, 8>(Kj, smem, (MT128 * 3) % G);
        GemmJob V{}; V.A = Hb + H_PROJ + 256; V.lda = 1056; V.Bt = Wb + W_UKV_OFF; V.K = 128; V.NR = 1024; V.nt0 = 2; V.ntn = 2; V.C = Hb + H_VTM; V.nfirst = 512; V.vrows = 512;
        gemm_run<2, 8>(V, smem, (MT128 * 5) % G);
      }
      xcd_barrier(xb);
      attn_dense_phase(p, smem, ctr + 0);
      xcd_barrier(xb);
      {
        GemmJob J{}; J.A = Ab; J.lda = DM; J.Bt = Wb + W_OUT_OFF; J.K = DM; J.NR = 1024; J.ablk = 1; J.nt0 = 0; J.ntn = 4; J.C = Hb; J.ldc = DM; J.nvalid = DM;
        gemm_run<1, 8>(J, smem, 0);
      }
      xcd_barrier(xb);
    } else {
      {
        GemmJob J{}; J.A = Ab; J.lda = DM; J.Bt = Wb + W_NAQKV_OFF; J.K = DM; J.NR = 3072; J.ablk = 1; J.nt0 = 0; J.ntn = 8; J.C = Hb + H_NAQK; J.ldc = 2048; J.nvalid = 2048;
        gemm_run<1, 8>(J, smem, 0);
        GemmJob V{}; V.A = Ab; V.lda = DM; V.Bt = Wb + W_NAQKV_OFF; V.K = DM; V.NR = 3072; V.ablk = 1; V.nt0 = 8; V.ntn = 4; V.C = Hb + H_VTN; V.nfirst = 2048; V.vrows = 1024;
        gemm_run<2, 8>(V, smem, (MT128 * 8) % G);
      }
      xcd_barrier(xb);
      attn_na_phase(p, smem, ctr + 1);
      xcd_barrier(xb);
      {
        GemmJob J{}; J.A = Ab; J.lda = DM; J.Bt = Wb + W_NAOUT_OFF; J.K = DM; J.NR = 1024; J.ablk = 1; J.nt0 = 0; J.ntn = 4; J.C = Hb; J.ldc = DM; J.nvalid = DM;
        gemm_run<1, 8>(J, smem, 0);
      }
      xcd_barrier(xb);
    }
    postnorm_phase(p, Hb, DM, 1.0f, gains + 3 * DM, gains + 4 * DM, 1, true, Ab, false);
    xcd_barrier(xb);
    {
      GemmJob J{}; J.A = Ab; J.lda = DM; J.Bt = Wb + (size_t)(li * 2 + 1) * W_FFN_EL; J.K = DM; J.NR = 5632; J.ablk = 1; J.nt0 = 0; J.ntn = 22; J.C = Hb; J.ldc = DFF;
      gemm_run<0, 8>(J, smem, 0);
    }
    xcd_barrier(xb);
    {
      GemmJob J{}; J.A = Hb; J.lda = DFF; J.Bt = Wb + (size_t)(li * 2 + 1) * W_FFN_EL + W_GU_EL; J.K = DFF; J.NR = 1024; J.ablk = 1; J.cblk = 1; J.rev = 1; J.nt0 = 0; J.ntn = 4; J.C = Ab; J.ldc = DM; J.nvalid = DM;
      gemm_run<1, 8>(J, smem, 0);
    }
    xcd_barrier(xb);
    if (li == 0) postnorm_phase(p, Ab, DM, 0.5f, gains + 5 * DM, gains + 6 * DM, 1, true, Ab, true);
    else         postnorm_phase(p, Ab, DM, 0.5f, gains + 5 * DM, nullptr, 1, true, nullptr, true);
    if (li == 0) xcd_barrier(xb);
  }
}

extern "C" void kernel_launch(void* const* d_in, const int* in_sizes, int n_in, void* d_out, int out_size,
                              void* d_ws, size_t ws_size, hipStream_t stream) {
  (void)in_sizes; (void)n_in; (void)out_size;
  if (ws_size < WS_NEED) { fprintf(stderr, "workspace too small: %zu < %zu\n", ws_size, (size_t)WS_NEED); return; }
  static int grid_blocks = 0;
  if (!grid_blocks) {
    int dev = 0, cus = 0, per_cu = 0;
    hipGetDevice(&dev);
    hipDeviceGetAttribute(&cus, hipDeviceAttributeMultiprocessorCount, dev);
    hipOccupancyMaxActiveBlocksPerMultiprocessor(&per_cu, fwd_megakernel, 256, 0);
    per_cu = 2;
    grid_blocks = cus * per_cu;
  }
  Params p{};
  p.x_prompt = (const float*)d_in[0]; p.x_sample = (const float*)d_in[1]; p.meta = (const float*)d_in[2]; p.norm_gains = (const float*)d_in[3];
  for (int i = 0; i < 6; ++i) p.ffn_w[i] = (const float*)d_in[4 + i];
  p.attn_w_in = (const float*)d_in[10]; p.mla_q_norm = (const float*)d_in[11]; p.mla_w_uq = (const float*)d_in[12];
  p.mla_kv_norm = (const float*)d_in[13]; p.mla_w_ukv = (const float*)d_in[14]; p.gqa_q_norm = (const float*)d_in[15];
  p.gqa_k_norm = (const float*)d_in[16]; p.attn_w_out = (const float*)d_in[17]; p.na_w_qkv = (const float*)d_in[18];
  p.na_rpb = (const float*)d_in[19]; p.na_meta_bias = (const float*)d_in[20]; p.na_w_out = (const float*)d_in[21];
  p.out = (float*)d_out; p.ws = (unsigned char*)d_ws;
  for (int i = 0; i < 16; ++i) p.inv_freq[i] = (float)(1.0 / pow(10000.0, (double)i / 16.0));
  (void)hipMemsetAsync(d_ws, 0, WS_TAB, stream);
  void* args[] = {&p};
  hipError_t e = hipLaunchCooperativeKernel((void*)fwd_megakernel, dim3(grid_blocks), dim3(256), args, 0, stream);
  if (e != hipSuccess) fprintf(stderr, "cooperative launch failed: %s (grid %d)\n", hipGetErrorString(e), grid_blocks);
}
```

```cpp
#include <hip/hip_runtime.h>
#include <hip/hip_cooperative_groups.h>
#include <cstdint>
#include <cstdio>
#include <cmath>
namespace cg = cooperative_groups;

typedef unsigned short bf16_t;
typedef short bf16x8 __attribute__((ext_vector_type(8)));
typedef float f32x4 __attribute__((ext_vector_type(4)));
typedef unsigned u32x4 __attribute__((ext_vector_type(4)));
typedef unsigned u32x2 __attribute__((ext_vector_type(2)));

#define DEVI __device__ __forceinline__
#define LDSP unsigned*

constexpr int MROWS = 49792;
constexpr int MT128 = 389;
constexpr int DM = 1024;
constexpr int DFF = 2816;
constexpr float EPSF = 1e-6f;
constexpr float LOG2E = 1.4426950408889634f;

constexpr size_t WS_CTR = 0;
constexpr size_t WS_BAR = 4096;
constexpr size_t WS_TAB = 4096 + 16384;
constexpr size_t WS_HM  = WS_TAB + 1052672;
constexpr size_t WS_W   = WS_HM + 655360;
constexpr size_t W_FFN_EL = 8650752;
constexpr size_t W_GU_EL = 5767168;
constexpr size_t W_IN_OFF   = 4 * W_FFN_EL;
constexpr size_t W_UQ_OFF   = W_IN_OFF + 1572864;
constexpr size_t W_UKV_OFF  = W_UQ_OFF + 196608;
constexpr size_t W_OUT_OFF  = W_UKV_OFF + 131072;
constexpr size_t W_NAQKV_OFF = W_OUT_OFF + 1048576;
constexpr size_t W_NAOUT_OFF = W_NAQKV_OFF + 3145728;
constexpr size_t W_TOTAL_EL = W_NAOUT_OFF + 1048576;
constexpr size_t WS_A = WS_W + W_TOTAL_EL * 2;
constexpr size_t WS_H = WS_A + (size_t)MROWS * 1024 * 2;
constexpr size_t H_PROJ = 0;
constexpr size_t H_QA   = (size_t)MROWS * 1056;
constexpr size_t H_KMLA = (size_t)MROWS * (1056 + 768);
constexpr size_t H_VTM  = (size_t)MROWS * 2592;
constexpr size_t H_VTG  = (size_t)MROWS * 3104;
constexpr size_t H_END0 = (size_t)MROWS * 3232;
constexpr size_t H_NAQK = 0;
constexpr size_t H_VTN  = (size_t)MROWS * 2048;
constexpr size_t WS_NEED = WS_H + H_END0 * 2;

struct Params {
  const float* x_prompt; const float* x_sample; const float* meta; const float* norm_gains;
  const float* ffn_w[6];
  const float* attn_w_in; const float* mla_q_norm; const float* mla_w_uq; const float* mla_kv_norm; const float* mla_w_ukv;
  const float* gqa_q_norm; const float* gqa_k_norm; const float* attn_w_out;
  const float* na_w_qkv; const float* na_rpb; const float* na_meta_bias; const float* na_w_out;
  float* out; unsigned char* ws;
  float inv_freq[16];
};

DEVI float bf2f(unsigned v) { return __uint_as_float(v << 16); }
DEVI float bflo(unsigned v) { return __uint_as_float(v << 16); }
DEVI float bfhi(unsigned v) { return __uint_as_float(v & 0xffff0000u); }
typedef __bf16 bf16x2_t __attribute__((ext_vector_type(2)));
typedef float f32x2_t __attribute__((ext_vector_type(2)));
DEVI unsigned pk2(float lo, float hi) { const f32x2_t v = {lo, hi}; const bf16x2_t b = __builtin_convertvector(v, bf16x2_t); return __builtin_bit_cast(unsigned, b); }
DEVI int otid() { int t = threadIdx.x; asm volatile("" : "+v"(t)); return t; }
DEVI float wave_sum(float v) {
#pragma unroll
  for (int o = 32; o >= 1; o >>= 1) v += __shfl_xor(v, o);
  return v;
}
DEVI void row_info(int r, int& s, int& t, int& Lr, int& kb) {
  if (r < 33280) { s = r / 4160; kb = s * 4160; t = r - kb; Lr = 4096; }
  else { int q = r - 33280; int ss = q / 8256; s = 8 + ss; kb = 33280 + ss * 8256; t = q - ss * 8256; Lr = 8192; }
}
DEVI size_t blk_off(int row, int col) { return ((size_t)(col >> 5) * MROWS + row) * 32 + (col & 31); }
DEVI int seq_base(int s) { return s < 8 ? s * 4160 : 33280 + (s - 8) * 8256; }
DEVI int seq_lr(int s) { return s < 8 ? 4096 : 8192; }
DEVI int out_base(int s) { return s < 8 ? s * 4096 : 32768 + (s - 8) * 8192; }

DEVI int wmap(int mode, int n0) {
  switch (mode) {
    case 1: return (n0 >> 5) * 64;
    case 2: return (n0 >> 5) * 64 + 32;
    case 3: if (n0 < 384) return n0; if (n0 < 416) return 1024 + (n0 - 384); if (n0 < 1056) return n0 - 32; return n0 + 224;
    case 4: { int h = n0 >> 7, c = n0 & 127; return c < 64 ? h * 64 + c : 512 + h * 64 + (c - 64); }
    default: return n0;
  }
}
DEVI void wt_transpose(const float* __restrict__ src, int K, int N, bf16_t* __restrict__ dst, int NR, int mode, unsigned char* smem, int rot) {
  float* tile = (float*)smem;
  const int tid = otid();
  const int ntn = N >> 5, ntk = K >> 6, ntiles = ntn * ntk;
  int start = (int)blockIdx.x - rot; if (start < 0) start += gridDim.x;
  for (int t = start; t < ntiles; t += gridDim.x) {
    const int kt = t / ntn, nt = t - kt * ntn;
    const int k0 = kt << 6, n0 = nt << 5;
    __syncthreads();
    {
      const int c = tid & 31, r0 = tid >> 5;
#pragma unroll
      for (int i = 0; i < 8; ++i) { const int r = r0 + i * 8; tile[r * 33 + c] = src[(size_t)(k0 + r) * N + n0 + c]; }
    }
    __syncthreads();
    {
      const int n = tid >> 3, kc = tid & 7;
      float v[8];
#pragma unroll
      for (int j = 0; j < 8; ++j) v[j] = tile[(kc * 8 + j) * 33 + n];
      u32x4 w; w.x = pk2(v[0], v[1]); w.y = pk2(v[2], v[3]); w.z = pk2(v[4], v[5]); w.w = pk2(v[6], v[7]);
      const int dr = wmap(mode, n0) + n;
      const int kk = k0 + kc * 8;
      *(u32x4*)(dst + ((size_t)(kk >> 5) * NR + dr) * 32 + (kk & 31)) = w;
    }
  }
}

DEVI void wt_transpose64(const float* __restrict__ src, int K, int N, bf16_t* __restrict__ dst, int NR, int mode, unsigned char* smem, int rot) {
  float* tile = (float*)smem;
  const int tid = otid();
  const int ntn = N >> 6, ntk = K >> 6, ntiles = ntn * ntk;
  int start = (int)blockIdx.x - rot; if (start < 0) start += gridDim.x;
  for (int t = start; t < ntiles; t += gridDim.x) {
    const int kt = t / ntn, nt = t - kt * ntn;
    const int k0 = kt << 6, n0 = nt << 6;
    __syncthreads();
    {
      const int c4 = tid & 15, r0 = tid >> 4;
#pragma unroll
      for (int i = 0; i < 4; ++i) {
        const int r = r0 + i * 16;
        const f32x4 v = __builtin_nontemporal_load((const f32x4*)(src + (size_t)(k0 + r) * N + n0 + c4 * 4));
        tile[r * 65 + c4 * 4 + 0] = v[0]; tile[r * 65 + c4 * 4 + 1] = v[1]; tile[r * 65 + c4 * 4 + 2] = v[2]; tile[r * 65 + c4 * 4 + 3] = v[3];
      }
    }
    __syncthreads();
    {
      const int n = tid >> 2, kq = tid & 3;
      float v[16];
#pragma unroll
      for (int j = 0; j < 16; ++j) v[j] = tile[(kq * 16 + j) * 65 + n];
      const int nn = n0 + n;
      const int dr = wmap(mode, nn & ~31) + (nn & 31);
      const int kk = k0 + kq * 16;
      bf16_t* dp = dst + ((size_t)(kk >> 5) * NR + dr) * 32 + (kk & 31);
      *(u32x4*)dp = (u32x4){pk2(v[0], v[1]), pk2(v[2], v[3]), pk2(v[4], v[5]), pk2(v[6], v[7])};
      *(u32x4*)(dp + 8) = (u32x4){pk2(v[8], v[9]), pk2(v[10], v[11]), pk2(v[12], v[13]), pk2(v[14], v[15])};
    }
  }
}

DEVI const float* h_src(const Params& p, int mode, int s, int t, int Lr) {
  if (t < Lr) {
    const int orow = out_base(s) + t;
    if (mode) return p.out + (size_t)orow * DM;
    return orow < 32768 ? p.x_prompt + (size_t)orow * DM : p.x_sample + (size_t)(orow - 32768) * DM;
  }
  const int j = t - Lr;
  if (mode) return (const float*)(p.ws + WS_HM) + (size_t)(s * 16 + j) * DM;
  return p.meta + (size_t)j * DM;
}
DEVI float* h_dst(const Params& p, int s, int t, int Lr) {
  if (t < Lr) return p.out + (size_t)(out_base(s) + t) * DM;
  return (float*)(p.ws + WS_HM) + (size_t)(s * 16 + (t - Lr)) * DM;
}

DEVI void postnorm_phase(const Params& p, const bf16_t* y, int ldy, float coef, const float* g_post, const float* g_pre,
                         int src_mode, bool write_h, bf16_t* a_out, bool yblk) {
  const int tid0 = otid();
  const int lane = tid0 & 63;
  const int gw = blockIdx.x * 4 + (tid0 >> 6), nw = gridDim.x * 4;
#pragma clang loop unroll(disable)
  for (int rp = gw; rp < MROWS / 2; rp += nw) {
    const int row0 = rp * 2;
    int s, t, Lr, kb; row_info(row0, s, t, Lr, kb);
    if (t >= Lr + 16) {
      if (a_out) {
#pragma unroll
        for (int u = 0; u < 2; ++u)
#pragma unroll
          for (int i = 0; i < 4; ++i) *(u32x2*)(a_out + blk_off(row0 + u, i * 256 + lane * 4)) = (u32x2){0u, 0u};
      }
      continue;
    }
    f32x4 h[2][4];
    u32x2 yw[2][4];
#pragma unroll
    for (int u = 0; u < 2; ++u) {
      const float* hs = h_src(p, src_mode, s, t + u, Lr);
#pragma unroll
      for (int i = 0; i < 4; ++i) h[u][i] = __builtin_nontemporal_load((const f32x4*)(hs + i * 256 + lane * 4));
      if (y) {
#pragma unroll
        for (int i = 0; i < 4; ++i)
          yw[u][i] = *(const u32x2*)(y + (yblk ? blk_off(row0 + u, i * 256 + lane * 4) : (size_t)(row0 + u) * ldy + i * 256 + lane * 4));
      }
    }
#pragma unroll
    for (int u = 0; u < 2; ++u) {
      if (y) {
        f32x4 yv[4]; float ss = 0.f;
#pragma unroll
        for (int i = 0; i < 4; ++i) {
          const u32x2 w = yw[u][i];
          yv[i] = (f32x4){bflo(w.x), bfhi(w.x), bflo(w.y), bfhi(w.y)};
          ss += yv[i][0] * yv[i][0] + yv[i][1] * yv[i][1] + yv[i][2] * yv[i][2] + yv[i][3] * yv[i][3];
        }
        ss = wave_sum(ss);
        const float rstd = rsqrtf(ss * (1.0f / DM) + EPSF) * coef;
#pragma unroll
        for (int i = 0; i < 4; ++i) {
          const f32x4 g = *(const f32x4*)(g_post + i * 256 + lane * 4);
          h[u][i] += yv[i] * rstd * g;
        }
      }
      if (write_h) {
        float* hd = h_dst(p, s, t + u, Lr);
#pragma unroll
        for (int i = 0; i < 4; ++i) __builtin_nontemporal_store(h[u][i], (f32x4*)(hd + i * 256 + lane * 4));
      }
    }
    if (a_out) {
#pragma unroll
      for (int u = 0; u < 2; ++u) {
        float ss = 0.f;
#pragma unroll
        for (int i = 0; i < 4; ++i) ss += h[u][i][0] * h[u][i][0] + h[u][i][1] * h[u][i][1] + h[u][i][2] * h[u][i][2] + h[u][i][3] * h[u][i][3];
        ss = wave_sum(ss);
        const float rstd = rsqrtf(ss * (1.0f / DM) + EPSF);
#pragma unroll
        for (int i = 0; i < 4; ++i) {
          const f32x4 g = *(const f32x4*)(g_pre + i * 256 + lane * 4);
          const f32x4 v = h[u][i] * rstd * g;
          *(u32x2*)(a_out + blk_off(row0 + u, i * 256 + lane * 4)) = (u32x2){pk2(v[0], v[1]), pk2(v[2], v[3])};
        }
      }
    }
  }
}

struct GemmJob {
  const bf16_t* A; int lda; const bf16_t* Bt; int K; int nt0, ntn;
  bf16_t* C; int ldc; int nvalid; int nfirst; int vrows; int NR; int ablk; int cblk; int rev;
  const float2* tab;
};
template <int OFF> DEVI bf16x8 ldsr(unsigned a) { bf16x8 v; asm volatile("ds_read_b128 %0, %1 offset:%2" : "=v"(v) : "v"(a), "n"(OFF)); return v; }
template <int TOP> DEVI void lgkm_wait(int i) {
  switch (TOP - i) {
    case 0: asm volatile("s_waitcnt lgkmcnt(0)" ::: "memory"); break;
    case 1: asm volatile("s_waitcnt lgkmcnt(1)" ::: "memory"); break;
    case 2: asm volatile("s_waitcnt lgkmcnt(2)" ::: "memory"); break;
    case 3: asm volatile("s_waitcnt lgkmcnt(3)" ::: "memory"); break;
    case 4: asm volatile("s_waitcnt lgkmcnt(4)" ::: "memory"); break;
    case 5: asm volatile("s_waitcnt lgkmcnt(5)" ::: "memory"); break;
    case 6: asm volatile("s_waitcnt lgkmcnt(6)" ::: "memory"); break;
    default: asm volatile("s_waitcnt lgkmcnt(7)" ::: "memory"); break;
  }
}
#define RAW_BARRIER() do { asm volatile("s_waitcnt lgkmcnt(0)" ::: "memory"); __builtin_amdgcn_s_barrier(); } while (0)

template <int EPI, int NB>
DEVI void gemm_epilogue(const GemmJob& J, f32x4 (&acc)[4][NB], int mbase, int nbase, int lane) {
  const int l16 = lane & 15, g = lane >> 4;
  if constexpr (EPI == 0) {
    const int fbase = (nbase >> 1) + g * 4;
#pragma unroll
    for (int mb = 0; mb < 4; ++mb) {
      const int rowi = mbase + mb * 16 + l16;
#pragma unroll
      for (int grp = 0; grp < NB / 4; ++grp)
#pragma unroll
        for (int nb = 0; nb < 2; ++nb) {
          float o[4];
#pragma unroll
          for (int r = 0; r < 4; ++r) {
            const float gv = acc[mb][grp * 4 + nb][r], uv = acc[mb][grp * 4 + nb + 2][r];
            o[r] = gv * uv * __builtin_amdgcn_rcpf(1.0f + __expf(-gv));
          }
          *(u32x2*)(J.C + blk_off(rowi, fbase + grp * 32 + nb * 16)) = (u32x2){pk2(o[0], o[1]), pk2(o[2], o[3])};
        }
    }
  } else if constexpr (EPI == 1 || EPI == 3 || EPI == 4) {
    if constexpr (EPI == 3) {
#pragma unroll
      for (int mb = 0; mb < 4; ++mb) {
        int s, t, Lr, kb; row_info(mbase + mb * 16 + l16, s, t, Lr, kb);
        const int pos = t < Lr ? 16 + t : t - Lr;
        const float2* tp = J.tab + pos * 16 + g * 4;
#pragma unroll
        for (int nb = 0; nb < NB - 1; ++nb) {
          if ((((nbase >> 4) + nb) % 6) == 4) {
#pragma unroll
            for (int r = 0; r < 4; ++r) {
              const float2 cs = tp[r];
              const float x1 = acc[mb][nb][r], x2 = acc[mb][nb + 1][r];
              acc[mb][nb][r] = x1 * cs.x - x2 * cs.y;
              acc[mb][nb + 1][r] = x2 * cs.x + x1 * cs.y;
            }
          }
        }
      }
    }
#pragma unroll
    for (int mb = 0; mb < 4; ++mb) {
      bf16_t* rowp = J.C + (size_t)(mbase + mb * 16 + l16) * J.ldc;
#pragma unroll
      for (int nb = 0; nb < NB; ++nb) {
        const int n = nbase + nb * 16 + g * 4;
        int col = n;
        if constexpr (EPI == 4) col = (n >> 6) * 96 + (n & 63);
        if (n < J.nvalid) {
          bf16_t* dp = rowp + col;
          if constexpr (EPI == 1) { if (J.cblk) dp = J.C + blk_off(mbase + mb * 16 + l16, col); }
          *(u32x2*)dp = (u32x2){pk2(acc[mb][nb][0], acc[mb][nb][1]), pk2(acc[mb][nb][2], acc[mb][nb][3])};
        }
      }
    }
  } else {
#pragma unroll
    for (int mb = 0; mb < 4; ++mb) {
      int s, t, Lr, kb; row_info(mbase + mb * 16, s, t, Lr, kb);
      const int Lk = Lr + 64;
      bf16_t* basep = J.C + (size_t)J.vrows * kb + t + g * 4;
#pragma unroll
      for (int nb = 0; nb < NB; ++nb) {
        const int vr = nbase + nb * 16 + l16 - J.nfirst;
        if (vr < J.vrows)
          *(u32x2*)(basep + (size_t)vr * Lk) = (u32x2){pk2(acc[mb][nb][0], acc[mb][nb][1]), pk2(acc[mb][nb][2], acc[mb][nb][3])};
      }
    }
  }
}

template <int EPI, int NB>
DEVI void gemm_tile(const GemmJob& J, int m0, int n0, unsigned char* smem) {
  constexpr bool SWAP = (EPI != 2);
  constexpr int BN = NB * 32;
  constexpr int A_BYTES = 128 * 64;
  constexpr int STG = A_BYTES + BN * 64;
  constexpr int S = (NB == 8) ? 3 : 4;
  constexpr int LB = BN / 64;
  const int tid = otid(), lane = tid & 63, wid = tid >> 6, wm = wid >> 1, wn = wid & 1;
  const int l16 = lane & 15, g = lane >> 4;
  f32x4 acc[4][NB];
#pragma unroll
  for (int i = 0; i < 4; ++i)
#pragma unroll
    for (int j = 0; j < NB; ++j) acc[i][j] = (f32x4){0.f, 0.f, 0.f, 0.f};
  const int srow = tid >> 2, sch = tid & 3;
  const int gch = sch ^ ((0 - (tid >> 4)) & 3);
  const bf16_t* Ag = J.A + (size_t)(m0 + srow) * (J.ablk ? 32 : J.lda) + gch * 8;
  const bf16_t* Bg = J.Bt + (size_t)(n0 + srow) * 32 + gch * 8;
  const size_t Astep = (size_t)64 * (J.ablk ? 32 : J.lda), Ak = J.ablk ? (size_t)MROWS * 32 : (size_t)32, Bstep = (size_t)64 * 32, Bk = (size_t)J.NR * 32;
  const int nk = J.K >> 5;
  unsigned char* lds_t = smem + tid * 16;
  const unsigned lbase = (unsigned)(uintptr_t)(__attribute__((address_space(3))) unsigned char*)smem;
#define GEMM_ISSUE(kt_, st_) do { \
    unsigned char* st__ = lds_t + (st_) * STG; \
    _Pragma("unroll") for (int i = 0; i < 2; ++i) \
      __builtin_amdgcn_global_load_lds((const unsigned*)(Ag + i * Astep + (size_t)(kt_) * Ak), (LDSP)(st__ + i * 4096), 16, 0, 0); \
    _Pragma("unroll") for (int i = 0; i < LB; ++i) \
      __builtin_amdgcn_global_load_lds((const unsigned*)(Bg + i * Bstep + (size_t)(kt_) * Bk), (LDSP)(st__ + A_BYTES + i * 4096), 16, 0, 0); \
  } while (0)
  asm volatile("s_waitcnt vmcnt(0)" ::: "memory");
  RAW_BARRIER();
#pragma unroll
  for (int st = 0; st < S - 1; ++st) GEMM_ISSUE(st, st);
  const int fsl = (g ^ ((0 - (l16 >> 2)) & 3)) << 4;
  const int aofs = (wm * 64 + l16) * 64 + fsl;
  const int bofs = A_BYTES + (wn * NB * 16 + l16) * 64 + fsl;
  int cs = 0, is = S - 1;
#pragma clang loop unroll(disable)
  for (int kt = 0; kt < nk; ++kt) {
    if (nk - 1 - kt >= S - 2) {
      if constexpr (NB == 8) asm volatile("s_waitcnt vmcnt(6)" ::: "memory");
      else                   asm volatile("s_waitcnt vmcnt(8)" ::: "memory");
    } else {
      asm volatile("s_waitcnt vmcnt(0)" ::: "memory");
    }
    RAW_BARRIER();
    if (kt + S - 1 < nk) GEMM_ISSUE(kt + S - 1, is);
    is = (is + 1 == S) ? 0 : is + 1;
    const unsigned cur = lbase + cs * STG;
    cs = (cs + 1 == S) ? 0 : cs + 1;
    bf16x8 af[4], bfr[NB];
    const unsigned aa = cur + aofs, ba = cur + bofs;
    af[0] = ldsr<0>(aa); af[1] = ldsr<1024>(aa); af[2] = ldsr<2048>(aa); af[3] = ldsr<3072>(aa);
    bfr[0] = ldsr<0>(ba); bfr[1] = ldsr<1024>(ba); bfr[2] = ldsr<2048>(ba); bfr[3] = ldsr<3072>(ba);
    __builtin_amdgcn_s_setprio(1);
#pragma unroll
    for (int nb = 0; nb < NB; ++nb) {
      if (nb == 0) asm volatile("s_waitcnt lgkmcnt(3)" : "+v"(af[0]), "+v"(af[1]), "+v"(af[2]), "+v"(af[3]), "+v"(bfr[0]) :: "memory");
      else if (nb <= NB - 4) asm volatile("s_waitcnt lgkmcnt(3)" : "+v"(bfr[nb]) :: "memory");
      else if (nb == NB - 3) asm volatile("s_waitcnt lgkmcnt(2)" : "+v"(bfr[nb]) :: "memory");
      else if (nb == NB - 2) asm volatile("s_waitcnt lgkmcnt(1)" : "+v"(bfr[nb]) :: "memory");
      else asm volatile("s_waitcnt lgkmcnt(0)" : "+v"(bfr[nb]) :: "memory");
      __builtin_amdgcn_sched_barrier(0);
#pragma unroll
      for (int mb = 0; mb < 4; ++mb) {
        if constexpr (SWAP) acc[mb][nb] = __builtin_amdgcn_mfma_f32_16x16x32_bf16(bfr[nb], af[mb], acc[mb][nb], 0, 0, 0);
        else                acc[mb][nb] = __builtin_amdgcn_mfma_f32_16x16x32_bf16(af[mb], bfr[nb], acc[mb][nb], 0, 0, 0);
      }
      if constexpr (NB == 8) {
        __builtin_amdgcn_sched_barrier(0);
        if (nb == 0) bfr[4] = ldsr<4096>(ba);
        if (nb == 1) bfr[5] = ldsr<5120>(ba);
        if (nb == 2) bfr[6] = ldsr<6144>(ba);
        if (nb == 3) bfr[7] = ldsr<7168>(ba);
      }
    }
    __builtin_amdgcn_s_setprio(0);
  }
#undef GEMM_ISSUE
  gemm_epilogue<EPI, NB>(J, acc, m0 + wm * 64, n0 + wn * NB * 16, lane);
}

template <int EPI, int NB>
DEVI void gemm_run(const GemmJob& J, unsigned char* smem, int rot) {
  constexpr int BN = NB * 32;
  const int G = gridDim.x;
  int b = (int)blockIdx.x - rot; if (b < 0) b += G;
  if (G & 7) {
    const int ntiles = MT128 * J.ntn;
    for (int t = b; t < ntiles; t += G) {
      const int mt = t / J.ntn, nt = J.nt0 + (t - mt * J.ntn);
      gemm_tile<EPI, NB>(J, mt * 128, nt * BN, smem);
    }
  } else {
    const int x = b & 7, lb = b >> 3, nlb = G >> 3;
    const int mlo = x * 49;
    const int mcnt = min(49, MT128 - mlo);
    const int ntot = mcnt * J.ntn, gsz = 8 * J.ntn;
    const int ngrp = (mcnt + 7) >> 3;
    for (int q0 = lb; q0 < ntot; q0 += nlb) {
      const int q = J.rev ? ntot - 1 - q0 : q0;
      int grp = q / gsz; const int qq = q - grp * gsz;
      const int mg = min(8, mcnt - grp * 8);
      const int nt = qq / mg, mi = qq - nt * mg;
      gemm_tile<EPI, NB>(J, (mlo + grp * 8 + mi) * 128, (J.nt0 + nt) * BN, smem);
    }
  }
  __syncthreads();
}

DEVI void head_norm_rope8(bf16_t* ptr, int lane, const float* gain, float rowp, float colp, const float2* tab, bool do_store) {
  const int k8 = lane & 7;
  const u32x4 w = *(const u32x4*)ptr;
  float x[8] = {bflo(w.x), bfhi(w.x), bflo(w.y), bfhi(w.y), bflo(w.z), bfhi(w.z), bflo(w.w), bfhi(w.w)};
  float ss = 0.f;
#pragma unroll
  for (int j = 0; j < 8; ++j) ss += x[j] * x[j];
  ss += __shfl_xor(ss, 1); ss += __shfl_xor(ss, 2); ss += __shfl_xor(ss, 4);
  const float rstd = rsqrtf(ss * (1.0f / 64.0f) + EPSF);
  const float pos = (k8 < 4) ? rowp : colp;
  const int ip = (int)fabsf(pos);
  const float sgn = pos < 0.f ? -1.f : 1.f;
  const bool first = !(k8 & 2);
  float o[8];
#pragma unroll
  for (int j = 0; j < 8; ++j) {
    const float xn = x[j] * rstd * gain[k8 * 8 + j];
    const float pr = __shfl_xor(xn, 2);
    const float2 cs = tab[ip * 16 + (k8 & 1) * 8 + j];
    const float sn = cs.y * sgn;
    o[j] = first ? (xn * cs.x - pr * sn) : (xn * cs.x + pr * sn);
  }
  if (do_store) *(u32x4*)ptr = (u32x4){pk2(o[0], o[1]), pk2(o[2], o[3]), pk2(o[4], o[5]), pk2(o[6], o[7])};
}

DEVI void split_phase(const Params& p) {
  bf16_t* Hb = (bf16_t*)(p.ws + WS_H);
  bf16_t* proj = Hb + H_PROJ;
  bf16_t* kmla = Hb + H_KMLA;
  const float2* tab = (const float2*)(p.ws + WS_TAB);
  const int tid0 = otid();
  const int lane = tid0 & 63;
  const int gw = blockIdx.x * 4 + (tid0 >> 6), nw = gridDim.x * 4;
  for (int row = gw; row < MROWS; row += nw) {
    int s, t, Lr, kb; row_info(row, s, t, Lr, kb);
    const bool ismeta = t >= Lr;
    const int posA = ismeta ? t - Lr : 16 + t;
    const float rowp = ismeta ? -1.f : (float)(t >> 6);
    const float colp = ismeta ? (float)(t - Lr) : (float)(t & 63);
    bf16_t* pr = proj + (size_t)row * 1056;
    {
      const u32x2 w = *(const u32x2*)(pr + lane * 4);
      const float x0 = bflo(w.x), x1 = bfhi(w.x), x2 = bflo(w.y), x3 = bfhi(w.y);
      const float ss = wave_sum(x0 * x0 + x1 * x1 + x2 * x2 + x3 * x3);
      const float rstd = rsqrtf(ss * (1.0f / 256.0f) + EPSF);
      const f32x4 g = *(const f32x4*)(p.mla_q_norm + lane * 4);
      *(u32x2*)(pr + lane * 4) = (u32x2){pk2(x0 * rstd * g[0], x1 * rstd * g[1]), pk2(x2 * rstd * g[2], x3 * rstd * g[3])};
    }
    {
      const unsigned w = *(const unsigned*)(pr + 256 + lane * 2);
      const float x0 = bflo(w), x1 = bfhi(w);
      const float ss = wave_sum(x0 * x0 + x1 * x1);
      const float rstd = rsqrtf(ss * (1.0f / 128.0f) + EPSF);
      *(unsigned*)(pr + 256 + lane * 2) = pk2(x0 * rstd * p.mla_kv_norm[lane * 2], x1 * rstd * p.mla_kv_norm[lane * 2 + 1]);
    }
    head_norm_rope8(pr + 384 + lane * 8, lane, p.gqa_q_norm, rowp, colp, tab, true);
    head_norm_rope8(pr + 896 + (lane & 15) * 8, lane, p.gqa_k_norm, rowp, colp, tab, lane < 16);
    {
      const int d = lane & 31;
      const float x = bf2f(pr[1024 + d]);
      const float pr2 = __shfl_xor(x, 16);
      const float2 cs = tab[posA * 16 + (d & 15)];
      const float o = (d < 16) ? (x * cs.x - pr2 * cs.y) : (x * cs.x + pr2 * cs.y);
      const unsigned ob = pk2(o, o) & 0xffffu;
      if (lane < 32) {
        bf16_t* kd = kmla + (size_t)row * 768 + 64 + d;
#pragma unroll
        for (int h = 0; h < 8; ++h) kd[h * 96] = (bf16_t)ob;
      }
    }
  }
}

constexpr int ATT_STAGE = 20480;
constexpr int ATT_BIAS_OFF = 61440;
struct AttnArgs {
  const bf16_t* Q; int ldq;
  const bf16_t* K; int ldk;
  const bf16_t* Vt; int Lk;
  bf16_t* O; int orow0, ocol0;
  int nq;
  int first, nreg, Lr;
  float sc2;
  int R, rs;
};

template <int OFF> DEVI u32x2 ldsr64(unsigned a) { u32x2 v; asm volatile("ds_read_b64 %0, %1 offset:%2" : "=v"(v) : "v"(a), "n"(OFF)); return v; }
DEVI float ldsr32(unsigned a) { float v; asm volatile("ds_read_b32 %0, %1" : "=v"(v) : "v"(a)); return v; }
DEVI float xmax16(float x) { auto r = __builtin_amdgcn_permlane16_swap(__float_as_uint(x), __float_as_uint(x), false, false); return fmaxf(__uint_as_float(r[0]), __uint_as_float(r[1])); }
DEVI float xmax32(float x) { auto r = __builtin_amdgcn_permlane32_swap(__float_as_uint(x), __float_as_uint(x), false, false); return fmaxf(__uint_as_float(r[0]), __uint_as_float(r[1])); }
DEVI float xsum16(float x) { auto r = __builtin_amdgcn_permlane16_swap(__float_as_uint(x), __float_as_uint(x), false, false); return __uint_as_float(r[0]) + __uint_as_float(r[1]); }
DEVI float xsum32(float x) { auto r = __builtin_amdgcn_permlane32_swap(__float_as_uint(x), __float_as_uint(x), false, false); return __uint_as_float(r[0]) + __uint_as_float(r[1]); }

template <int DK, int QB, bool NA>
DEVI void attn_item(const AttnArgs& a, unsigned char* smem) {
  constexpr int KS = DK / 32;
  constexpr int S = 3;
  const int tid = otid(), lane = tid & 63, w = tid >> 6;
  const int l16 = lane & 15, g = lane >> 4;
  const bool wact = (w * QB * 16) < a.nq;
  const int nt = a.nreg + 1;
  const unsigned lbase = (unsigned)(uintptr_t)(__attribute__((address_space(3))) unsigned char*)smem;

  bf16x8 qf[QB][KS];
#pragma unroll
  for (int qb = 0; qb < QB; ++qb) {
    const bf16_t* qp = a.Q + (size_t)((wact ? w * QB * 16 : 0) + qb * 16 + l16) * a.ldq + g * 8;
#pragma unroll
    for (int ks = 0; ks < KS; ++ks) qf[qb][ks] = *(const bf16x8*)(qp + ks * 32);
  }
  float m[QB], l[QB];
  f32x4 o[4][QB];
#pragma unroll
  for (int qb = 0; qb < QB; ++qb) {
    m[qb] = NA ? -1e30f : 0.f; l[qb] = 0.f;
#pragma unroll
    for (int db = 0; db < 4; ++db) o[db][qb] = (f32x4){0.f, 0.f, 0.f, 0.f};
  }
  const int r8 = tid >> 3, c8 = (tid & 7) ^ ((tid >> 4) & 7);
  const bf16_t* Kn = a.K + (size_t)r8 * a.ldk + c8 * 8;
  const bf16_t* Kr = a.K + (size_t)(tid >> 2) * a.ldk + 64 + (((tid & 3) ^ ((0 - (tid >> 4)) & 3)) * 8);
  const bf16_t* Vg = a.Vt + (size_t)r8 * a.Lk + c8 * 8;
  const size_t kstep = (size_t)32 * a.ldk, vstep = (size_t)32 * a.Lk;
  unsigned char* lds_t = smem + tid * 16;
#define ATT_ISSUE(j_, st_) do { \
    const int ko__ = ((j_) < a.nreg) ? (a.first + (j_)) * 64 : a.Lr; \
    unsigned char* st__ = lds_t + (st_) * ATT_STAGE; \
    const bf16_t* kp__ = Kn + (size_t)ko__ * a.ldk; \
    __builtin_amdgcn_global_load_lds((const unsigned*)(kp__), (LDSP)(st__), 16, 0, 0); \
    __builtin_amdgcn_global_load_lds((const unsigned*)(kp__ + kstep), (LDSP)(st__ + 4096), 16, 0, 0); \
    if constexpr (DK == 96) __builtin_amdgcn_global_load_lds((const unsigned*)(Kr + (size_t)ko__ * a.ldk), (LDSP)(st__ + 8192), 16, 0, 0); \
    __builtin_amdgcn_global_load_lds((const unsigned*)(Vg + ko__), (LDSP)(st__ + 12288), 16, 0, 0); \
    __builtin_amdgcn_global_load_lds((const unsigned*)(Vg + vstep + ko__), (LDSP)(st__ + 12288 + 4096), 16, 0, 0); \
  } while (0)
  asm volatile("s_waitcnt vmcnt(0)" ::: "memory");
  RAW_BARRIER();
  ATT_ISSUE(0, 0);
  if (nt > 1) ATT_ISSUE(1, 1);
  const int sw8 = (l16 >> 1) & 7, vsw = sw8 << 1;
  const unsigned ka0 = l16 * 128 + ((g ^ sw8) << 4), ka1 = l16 * 128 + (((4 + g) ^ sw8) << 4);
  const unsigned kr = 8192 + l16 * 64 + ((g ^ ((0 - (l16 >> 2)) & 3)) << 4);
  const unsigned vb00 = 12288 + l16 * 128 + (((0 + g) ^ vsw) << 3), vb01 = 12288 + l16 * 128 + (((4 + g) ^ vsw) << 3);
  const unsigned vb10 = 12288 + l16 * 128 + (((8 + g) ^ vsw) << 3), vb11 = 12288 + l16 * 128 + (((12 + g) ^ vsw) << 3);
  const unsigned biasA = lbase + ATT_BIAS_OFF;
  const int qc = w * 16 + l16;
  const int cs0 = min(max(qc - 8, 0), 48);
  int cs = 0, is = 2;
  for (int j = 0; j < nt; ++j) {
    if (j + 1 < nt) {
      if constexpr (DK == 96) asm volatile("s_waitcnt vmcnt(5)" ::: "memory");
      else                    asm volatile("s_waitcnt vmcnt(4)" ::: "memory");
    } else {
      asm volatile("s_waitcnt vmcnt(0)" ::: "memory");
    }
    RAW_BARRIER();
    if (j + 2 < nt) ATT_ISSUE(j + 2, is);
    is = (is + 1 == S) ? 0 : is + 1;
    const unsigned cur = lbase + cs * ATT_STAGE;
    cs = (cs + 1 == S) ? 0 : cs + 1;
    if (wact) {
      f32x4 s[4][QB];
#pragma unroll
      for (int kb = 0; kb < 4; ++kb)
#pragma unroll
        for (int qb = 0; qb < QB; ++qb) s[kb][qb] = (f32x4){0.f, 0.f, 0.f, 0.f};
      {
        bf16x8 k0[4], k1[4], k2[4];
        const unsigned a0 = cur + ka0, a1 = cur + ka1, a2 = cur + kr;
        k0[0] = ldsr<0>(a0); k0[1] = ldsr<2048>(a0); k0[2] = ldsr<4096>(a0); k0[3] = ldsr<6144>(a0);
        k1[0] = ldsr<0>(a1); k1[1] = ldsr<2048>(a1); k1[2] = ldsr<4096>(a1); k1[3] = ldsr<6144>(a1);
        if constexpr (KS == 3) { k2[0] = ldsr<0>(a2); k2[1] = ldsr<1024>(a2); k2[2] = ldsr<2048>(a2); k2[3] = ldsr<3072>(a2); }
        if constexpr (KS == 3) asm volatile("s_waitcnt lgkmcnt(8)" : "+v"(k0[0]), "+v"(k0[1]), "+v"(k0[2]), "+v"(k0[3]) :: "memory");
        else                   asm volatile("s_waitcnt lgkmcnt(4)" : "+v"(k0[0]), "+v"(k0[1]), "+v"(k0[2]), "+v"(k0[3]) :: "memory");
        __builtin_amdgcn_sched_barrier(0);
#pragma unroll
        for (int kb = 0; kb < 4; ++kb)
#pragma unroll
          for (int qb = 0; qb < QB; ++qb) s[kb][qb] = __builtin_amdgcn_mfma_f32_16x16x32_bf16(k0[kb], qf[qb][0], s[kb][qb], 0, 0, 0);
        if constexpr (KS == 3) asm volatile("s_waitcnt lgkmcnt(4)" : "+v"(k1[0]), "+v"(k1[1]), "+v"(k1[2]), "+v"(k1[3]) :: "memory");
        else                   asm volatile("s_waitcnt lgkmcnt(0)" : "+v"(k1[0]), "+v"(k1[1]), "+v"(k1[2]), "+v"(k1[3]) :: "memory");
        __builtin_amdgcn_sched_barrier(0);
#pragma unroll
        for (int kb = 0; kb < 4; ++kb)
#pragma unroll
          for (int qb = 0; qb < QB; ++qb) s[kb][qb] = __builtin_amdgcn_mfma_f32_16x16x32_bf16(k1[kb], qf[qb][1], s[kb][qb], 0, 0, 0);
        if constexpr (KS == 3) {
          asm volatile("s_waitcnt lgkmcnt(0)" : "+v"(k2[0]), "+v"(k2[1]), "+v"(k2[2]), "+v"(k2[3]) :: "memory");
          __builtin_amdgcn_sched_barrier(0);
#pragma unroll
          for (int kb = 0; kb < 4; ++kb)
#pragma unroll
            for (int qb = 0; qb < QB; ++qb) s[kb][qb] = __builtin_amdgcn_mfma_f32_16x16x32_bf16(k2[kb], qf[qb][2], s[kb][qb], 0, 0, 0);
        }
      }
      u32x2 va[2][4], vbq[2][4];
      {
        const unsigned p00 = cur + vb00, p01 = cur + vb01, p10 = cur + vb10, p11 = cur + vb11;
        va[0][0] = ldsr64<0>(p00); vbq[0][0] = ldsr64<0>(p01); va[0][1] = ldsr64<2048>(p00); vbq[0][1] = ldsr64<2048>(p01);
        va[0][2] = ldsr64<4096>(p00); vbq[0][2] = ldsr64<4096>(p01); va[0][3] = ldsr64<6144>(p00); vbq[0][3] = ldsr64<6144>(p01);
        va[1][0] = ldsr64<0>(p10); vbq[1][0] = ldsr64<0>(p11); va[1][1] = ldsr64<2048>(p10); vbq[1][1] = ldsr64<2048>(p11);
        va[1][2] = ldsr64<4096>(p10); vbq[1][2] = ldsr64<4096>(p11); va[1][3] = ldsr64<6144>(p10); vbq[1][3] = ldsr64<6144>(p11);
      }
      const bool ismeta = (j == nt - 1);
      bf16x8 pf[QB][2];
      if constexpr (!NA) {
        typedef float f32x2 __attribute__((ext_vector_type(2)));
#pragma unroll
        for (int qb = 0; qb < QB; ++qb) {
          if (ismeta) {
#pragma unroll
            for (int kb = 1; kb < 4; ++kb) s[kb][qb] = (f32x4){-1e30f, -1e30f, -1e30f, -1e30f};
          }
          const f32x2 scv = {a.sc2, a.sc2}, nmv = {-m[qb], -m[qb]};
          f32x2 t[4][2];
#pragma unroll
          for (int kb = 0; kb < 4; ++kb)
#pragma unroll
            for (int h = 0; h < 2; ++h) {
              const f32x2 sv = {s[kb][qb][2 * h], s[kb][qb][2 * h + 1]};
              t[kb][h] = sv * scv + nmv;
            }
          float mx = fmaxf(t[0][0].x, t[0][0].y);
#pragma unroll
          for (int kb = 0; kb < 4; ++kb)
#pragma unroll
            for (int h = 0; h < 2; ++h) mx = fmaxf(mx, fmaxf(t[kb][h].x, t[kb][h].y));
          if (j == 0 || __any(mx > 6.f)) {
            mx = xmax32(xmax16(mx));
            const float d = (j == 0) ? mx : fmaxf(mx, 0.f);
            const float alpha = __builtin_amdgcn_exp2f(-d);
            const f32x2 dv = {d, d};
#pragma unroll
            for (int kb = 0; kb < 4; ++kb)
#pragma unroll
              for (int h = 0; h < 2; ++h) t[kb][h] -= dv;
            m[qb] += d;
            l[qb] *= alpha;
#pragma unroll
            for (int db = 0; db < 4; ++db) o[db][qb] *= alpha;
          }
          f32x2 ls2 = {0.f, 0.f};
          unsigned pw[2][4];
#pragma unroll
          for (int kb = 0; kb < 4; ++kb)
#pragma unroll
            for (int h = 0; h < 2; ++h) {
              const f32x2 pe = {__builtin_amdgcn_exp2f(t[kb][h].x), __builtin_amdgcn_exp2f(t[kb][h].y)};
              ls2 += pe;
              pw[kb >> 1][(kb & 1) * 2 + h] = pk2(pe.x, pe.y);
            }
          l[qb] += ls2.x + ls2.y;
#pragma unroll
          for (int c = 0; c < 2; ++c) {
            const u32x4 pv = (u32x4){pw[c][0], pw[c][1], pw[c][2], pw[c][3]};
            pf[qb][c] = __builtin_bit_cast(bf16x8, pv);
          }
        }
      } else {
#pragma unroll
      for (int qb = 0; qb < QB; ++qb) {
        float tv[4][4];
#pragma unroll
        for (int kb = 0; kb < 4; ++kb)
#pragma unroll
          for (int r = 0; r < 4; ++r) tv[kb][r] = s[kb][qb][r] * a.sc2;
        if (ismeta) {
          if constexpr (NA) {
            float bv[4];
#pragma unroll
            for (int r = 0; r < 4; ++r) bv[r] = ldsr32(biasA + (480 + g * 4 + r) * 4);
            asm volatile("s_waitcnt lgkmcnt(0)" : "+v"(bv[0]), "+v"(bv[1]), "+v"(bv[2]), "+v"(bv[3]) :: "memory");
            __builtin_amdgcn_sched_barrier(0);
#pragma unroll
            for (int r = 0; r < 4; ++r) tv[0][r] += bv[r];
          }
#pragma unroll
          for (int r = 0; r < 4; ++r) { tv[1][r] = -1e30f; tv[2][r] = -1e30f; tv[3][r] = -1e30f; }
        } else if constexpr (NA) {
          const int ro = (a.rs + j - a.R + 7) * 31 + 15 - qc;
          float bv[4][4];
#pragma unroll
          for (int kb = 0; kb < 4; ++kb)
#pragma unroll
            for (int r = 0; r < 4; ++r) {
              const int kc = kb * 16 + g * 4 + r;
              const bool in = (kc >= cs0) && (kc < cs0 + 16);
              bv[kb][r] = ldsr32(biasA + (in ? ro + kc : 0) * 4);
            }
          asm volatile("s_waitcnt lgkmcnt(0)"
                       : "+v"(bv[0][0]), "+v"(bv[0][1]), "+v"(bv[0][2]), "+v"(bv[0][3]), "+v"(bv[1][0]), "+v"(bv[1][1]), "+v"(bv[1][2]), "+v"(bv[1][3]),
                         "+v"(bv[2][0]), "+v"(bv[2][1]), "+v"(bv[2][2]), "+v"(bv[2][3]), "+v"(bv[3][0]), "+v"(bv[3][1]), "+v"(bv[3][2]), "+v"(bv[3][3])
                       :: "memory");
          __builtin_amdgcn_sched_barrier(0);
#pragma unroll
          for (int kb = 0; kb < 4; ++kb)
#pragma unroll
            for (int r = 0; r < 4; ++r) {
              const int kc = kb * 16 + g * 4 + r;
              const bool in = (kc >= cs0) && (kc < cs0 + 16);
              tv[kb][r] = in ? tv[kb][r] + bv[kb][r] : -1e30f;
            }
        }
        float mx = tv[0][0];
#pragma unroll
        for (int kb = 0; kb < 4; ++kb)
#pragma unroll
          for (int r = 0; r < 4; ++r) mx = fmaxf(mx, tv[kb][r]);
        mx = xmax32(xmax16(mx));
        const float mn = fmaxf(m[qb], mx);
        const float alpha = __builtin_amdgcn_exp2f(m[qb] - mn);
        const bool changed = (mn != m[qb]);
        m[qb] = mn;
        float ls = 0.f;
#pragma unroll
        for (int kb = 0; kb < 4; ++kb)
#pragma unroll
          for (int r = 0; r < 4; ++r) { tv[kb][r] = __builtin_amdgcn_exp2f(tv[kb][r] - mn); ls += tv[kb][r]; }
        l[qb] = l[qb] * alpha + ls;
        if (__any(changed)) {
#pragma unroll
          for (int db = 0; db < 4; ++db) o[db][qb] *= alpha;
        }
#pragma unroll
        for (int c = 0; c < 2; ++c) {
          u32x4 pw;
          pw.x = pk2(tv[2 * c][0], tv[2 * c][1]); pw.y = pk2(tv[2 * c][2], tv[2 * c][3]);
          pw.z = pk2(tv[2 * c + 1][0], tv[2 * c + 1][1]); pw.w = pk2(tv[2 * c + 1][2], tv[2 * c + 1][3]);
          pf[qb][c] = __builtin_bit_cast(bf16x8, pw);
        }
      }
      }
      asm volatile("s_waitcnt lgkmcnt(0)"
                   : "+v"(va[0][0]), "+v"(va[0][1]), "+v"(va[0][2]), "+v"(va[0][3]), "+v"(va[1][0]), "+v"(va[1][1]), "+v"(va[1][2]), "+v"(va[1][3]),
                     "+v"(vbq[0][0]), "+v"(vbq[0][1]), "+v"(vbq[0][2]), "+v"(vbq[0][3]), "+v"(vbq[1][0]), "+v"(vbq[1][1]), "+v"(vbq[1][2]), "+v"(vbq[1][3])
                   :: "memory");
      __builtin_amdgcn_sched_barrier(0);
#pragma unroll
      for (int c = 0; c < 2; ++c)
#pragma unroll
        for (int db = 0; db < 4; ++db) {
          const u32x4 vw = (u32x4){va[c][db].x, va[c][db].y, vbq[c][db].x, vbq[c][db].y};
          const bf16x8 vf = __builtin_bit_cast(bf16x8, vw);
#pragma unroll
          for (int qb = 0; qb < QB; ++qb) o[db][qb] = __builtin_amdgcn_mfma_f32_16x16x32_bf16(vf, pf[qb][c], o[db][qb], 0, 0, 0);
        }
    }
  }
#undef ATT_ISSUE
  if (wact) {
#pragma unroll
    for (int qb = 0; qb < QB; ++qb) {
      const float lt = xsum32(xsum16(l[qb]));
      const float inv = 1.0f / lt;
      const int qi = w * QB * 16 + qb * 16 + l16;
      if (qi < a.nq) {
#pragma unroll
        for (int db = 0; db < 4; ++db) {
          const f32x4 v = o[db][qb] * inv;
          *(u32x2*)(a.O + blk_off(a.orow0 + qi, a.ocol0 + db * 16 + g * 4)) = (u32x2){pk2(v[0], v[1]), pk2(v[2], v[3])};
        }
      }
    }
  }
}

DEVI int next_item(unsigned* ctr, int* sh) {
  __syncthreads();
  if (threadIdx.x == 0) *sh = (int)atomicAdd(ctr, 1u);
  __syncthreads();
  return __builtin_amdgcn_readfirstlane(*sh);
}

DEVI void attn_dense_phase(const Params& p, unsigned char* smem, unsigned* ctr) {
  bf16_t* Hb = (bf16_t*)(p.ws + WS_H);
  bf16_t* Ob = (bf16_t*)(p.ws + WS_A);
  int* sh = (int*)(smem + 73600);
  constexpr int NITEMS = 2048 + 4096 + 160;
  for (;;) {
    const int it = next_item(ctr, sh);
    if (it >= NITEMS) break;
    int s, h16, qt, nq = 128;
    if (it < 160) { s = it >> 4; h16 = it & 15; qt = -1; nq = 16; }
    else if (it < 160 + 2048) { const int id = it - 160; qt = id & 63; const int shd = id >> 6; if (shd < 16) { s = 8 + (shd >> 3); h16 = shd & 7; } else { s = 8 + ((shd - 16) >> 3); h16 = 8 + ((shd - 16) & 7); } }
    else { const int id = it - 160 - 2048; qt = id & 31; const int shd = id >> 5; if (shd < 64) { s = shd >> 3; h16 = shd & 7; } else { s = (shd - 64) >> 3; h16 = 8 + ((shd - 64) & 7); } }
    const int kb = seq_base(s), Lr = seq_lr(s), Lk = Lr + 64;
    const int q0 = kb + (qt < 0 ? Lr : qt * 128);
    AttnArgs a;
    a.nq = nq; a.first = 0; a.nreg = Lr >> 6; a.Lr = Lr; a.Lk = Lk; a.R = 0; a.rs = 0;
    a.O = Ob; a.orow0 = q0; a.ocol0 = h16 * 64;
    if (h16 < 8) {
      a.Q = Hb + H_QA + (size_t)q0 * 768 + h16 * 96; a.ldq = 768;
      a.K = Hb + H_KMLA + (size_t)kb * 768 + h16 * 96; a.ldk = 768;
      a.Vt = Hb + H_VTM + (size_t)512 * kb + (size_t)(h16 * 64) * Lk;
      a.sc2 = 0.10206207261596577f * LOG2E;
      attn_item<96, 2, false>(a, smem);
    } else {
      const int hq = h16 - 8, kvh = hq >> 2;
      a.Q = Hb + H_PROJ + (size_t)q0 * 1056 + 384 + hq * 64; a.ldq = 1056;
      a.K = Hb + H_PROJ + (size_t)kb * 1056 + 896 + kvh * 64; a.ldk = 1056;
      a.Vt = Hb + H_VTG + (size_t)128 * kb + (size_t)(kvh * 64) * Lk;
      a.sc2 = 0.125f * LOG2E;
      attn_item<64, 2, false>(a, smem);
    }
  }
}

DEVI void attn_na_phase(const Params& p, unsigned char* smem, unsigned* ctr) {
  bf16_t* Hb = (bf16_t*)(p.ws + WS_H);
  bf16_t* Ob = (bf16_t*)(p.ws + WS_A);
  int* sh = (int*)(smem + 73600);
  float* biasL = (float*)(smem + ATT_BIAS_OFF);
  constexpr int NP = 8 * 16 * 65, NS = 2 * 16 * 129;
  for (;;) {
    const int it = next_item(ctr, sh);
    if (it >= NP + NS) break;
    int s, h, R, rows;
    if (it < NS) { const int sh2 = it / 129; R = it - sh2 * 129; s = 8 + (sh2 >> 4); h = sh2 & 15; rows = 128; }
    else { const int id = it - NS; const int sh2 = id / 65; R = id - sh2 * 65; s = sh2 >> 4; h = sh2 & 15; rows = 64; }
    const int kb = seq_base(s), Lr = seq_lr(s), Lk = Lr + 64;
    for (int i = threadIdx.x; i < 465; i += 256) biasL[i] = p.na_rpb[h * 465 + i] * LOG2E;
    if (threadIdx.x < 16) biasL[480 + threadIdx.x] = p.na_meta_bias[h * 16 + threadIdx.x] * LOG2E;
    AttnArgs a;
    a.Lr = Lr; a.Lk = Lk; a.sc2 = 0.125f * LOG2E;
    a.K = Hb + H_NAQK + (size_t)kb * 2048 + 1024 + h * 64; a.ldk = 2048;
    a.Vt = Hb + H_VTN + (size_t)1024 * kb + (size_t)(h * 64) * Lk;
    a.ldq = 2048;
    int q0;
    if (R < rows) { const int rs = min(max(R - 4, 0), rows - 8); a.R = R; a.rs = rs; a.first = rs; a.nreg = 8; a.nq = 64; q0 = kb + R * 64; }
    else { a.R = 0; a.rs = 0; a.first = 0; a.nreg = 0; a.nq = 16; q0 = kb + Lr; }
    a.Q = Hb + H_NAQK + (size_t)q0 * 2048 + h * 64;
    a.O = Ob; a.orow0 = q0; a.ocol0 = h * 64;
    attn_item<64, 1, true>(a, smem);
  }
}

#define XB_TMO      128
#define XB_XCNT(j)  (256  + 64 * (j))
#define XB_XSUB(j)  (1280 + 64 * (j))
#define XB_XGEN(j)  (2304 + 64 * (j))
#define XB_TOP      3328
#define XB_TOPGEN   3392
#define XCD_BAR_WORDS 3456
#define XB_SPIN_CAP (1u << 20)
#define LAS __attribute__((address_space(3)))
DEVI unsigned xb_ld(unsigned* p)              { return __hip_atomic_load(p, __ATOMIC_RELAXED, __HIP_MEMORY_SCOPE_AGENT); }
DEVI unsigned xb_add(unsigned* p, unsigned v) { return __hip_atomic_fetch_add(p, v, __ATOMIC_RELAXED, __HIP_MEMORY_SCOPE_AGENT); }
DEVI unsigned xb_xcc_id() { return (unsigned)__builtin_amdgcn_s_getreg((3 << 11) | 20) & 0xFu; }
#define XB_SPIN(cond, bar) do { unsigned _sp = 0; while (cond) { __builtin_amdgcn_s_sleep(1); \
    if ((++_sp & 255u) == 0u) { if (xb_ld(&(bar)[XB_TMO])) break; if (_sp > XB_SPIN_CAP) { atomicAdd(&(bar)[XB_TMO], 1u); break; } } } } while (0)
struct XcdBarrier { unsigned* bar; unsigned x; volatile LAS unsigned* st; };
DEVI XcdBarrier xcd_barrier_post(unsigned* bar, volatile LAS unsigned* st) {
  XcdBarrier b; b.bar = bar; b.x = xb_xcc_id(); b.st = st;
  if (threadIdx.x == 0) (void)xb_add(&bar[XB_XCNT(b.x)], 1u);
  return b;
}
DEVI void xcd_barrier_complete(unsigned* bar, unsigned x, unsigned& nloc, unsigned& nx) {
  const unsigned G = gridDim.x * gridDim.y * gridDim.z;
  unsigned sum, cnt, mine, sp = 0u;
  for (;;) {
    sum = 0u; cnt = 0u; mine = 0u;
#pragma unroll
    for (unsigned j = 0; j < 16; ++j) { const unsigned c = xb_ld(&bar[XB_XCNT(j)]); sum += c; cnt += (c > 0u) ? 1u : 0u; mine = (j == x) ? c : mine; }
    if (sum == G) break;
    __builtin_amdgcn_s_sleep(1);
    if ((++sp & 255u) == 0u) { if (xb_ld(&bar[XB_TMO])) break; if (sp > XB_SPIN_CAP) { atomicAdd(&bar[XB_TMO], 1u); break; } }
  }
  nloc = mine > 0u ? mine : 1u; nx = cnt > 0u ? cnt : 1u;
}
DEVI void xcd_barrier(const XcdBarrier& b) {
  asm volatile("s_waitcnt vmcnt(0)" ::: "memory");
  __syncthreads();
  if (threadIdx.x == 0) {
    unsigned* bar = b.bar;
    __builtin_amdgcn_s_waitcnt(0);
    unsigned nloc = b.st[0], nx = b.st[1];
    if (nloc == 0u) { xcd_barrier_complete(bar, b.x, nloc, nx); b.st[0] = nloc; b.st[1] = nx; }
    const unsigned old = xb_add(&bar[XB_XSUB(b.x)], 1u);
    const unsigned gen = old / nloc;
    if (old + 1u == (gen + 1u) * nloc) {
      __builtin_amdgcn_fence(__ATOMIC_RELEASE, "agent");
      asm volatile("s_waitcnt vmcnt(0)" ::: "memory");
      const unsigned og = xb_add(&bar[XB_TOP], 1u);
      const unsigned tg = og / nx;
      if (og + 1u == (tg + 1u) * nx) xb_add(&bar[XB_TOPGEN], 1u);
      else XB_SPIN(xb_ld(&bar[XB_TOPGEN]) == tg, bar);
      __builtin_amdgcn_fence(__ATOMIC_ACQUIRE, "agent");
      xb_add(&bar[XB_XGEN(b.x)], 1u);
      asm volatile("s_waitcnt vmcnt(0)" ::: "memory");
    } else {
      XB_SPIN(xb_ld(&bar[XB_XGEN(b.x)]) == gen, bar);
      __builtin_amdgcn_fence(__ATOMIC_ACQUIRE, "agent");
      asm volatile("s_waitcnt vmcnt(0)" ::: "memory");
    }
  }
  __syncthreads();
}

__global__ void __launch_bounds__(256, 2) fwd_megakernel(Params p) {
  cg::grid_group grid = cg::this_grid();
  __shared__ __attribute__((aligned(16))) unsigned char smem[73728];
  __shared__ uint4 xb_words;
  if (threadIdx.x == 0) xb_words = make_uint4(0u, 0u, 0u, 0u);
  __syncthreads();
  const XcdBarrier xb = xcd_barrier_post((unsigned*)(p.ws + WS_BAR), (volatile LAS unsigned*)&xb_words);
  const int G = gridDim.x;
  unsigned* ctr = (unsigned*)(p.ws + WS_CTR);
  bf16_t* Wb = (bf16_t*)(p.ws + WS_W);
  bf16_t* Ab = (bf16_t*)(p.ws + WS_A);
  bf16_t* Hb = (bf16_t*)(p.ws + WS_H);
  float2* tab = (float2*)(p.ws + WS_TAB);

  {
    int rot = 0;
    for (int li = 0; li < 2; ++li)
      for (int f = 0; f < 2; ++f) {
        bf16_t* wgu = Wb + (size_t)(li * 2 + f) * W_FFN_EL;
        wt_transpose64(p.ffn_w[f * 3 + 0] + (size_t)li * DM * DFF, DM, DFF, wgu, 5632, 1, smem, rot); rot = (rot + 704) % G;
        wt_transpose64(p.ffn_w[f * 3 + 1] + (size_t)li * DM * DFF, DM, DFF, wgu, 5632, 2, smem, rot); rot = (rot + 704) % G;
        wt_transpose64(p.ffn_w[f * 3 + 2] + (size_t)li * DM * DFF, DFF, DM, wgu + W_GU_EL, 1024, 0, smem, rot); rot = (rot + 704) % G;
      }
    wt_transpose(p.attn_w_in, DM, 1184, Wb + W_IN_OFF, 1536, 3, smem, rot); rot = (rot + 592) % G;
    wt_transpose(p.mla_w_uq, 256, 768, Wb + W_UQ_OFF, 768, 0, smem, rot); rot = (rot + 96) % G;
    wt_transpose(p.mla_w_ukv, 128, 1024, Wb + W_UKV_OFF, 1024, 4, smem, rot); rot = (rot + 64) % G;
    wt_transpose64(p.attn_w_out, DM, DM, Wb + W_OUT_OFF, 1024, 0, smem, rot); rot = (rot + 256) % G;
    wt_transpose64(p.na_w_qkv, DM, 3072, Wb + W_NAQKV_OFF, 3072, 0, smem, rot); rot = (rot + 768) % G;
    wt_transpose64(p.na_w_out, DM, DM, Wb + W_NAOUT_OFF, 1024, 0, smem, rot);
    {
      for (int i = blockIdx.x * 256 + threadIdx.x; i < 32 * 352 * 4; i += G * 256) {
        const int q4 = i & 3, rr = (i >> 2) % 352, kbk = (i >> 2) / 352;
        const int r = rr < 224 ? 1056 + rr : 1408 + (rr - 224);
        *(u32x4*)(Wb + W_IN_OFF + ((size_t)kbk * 1536 + r) * 32 + q4 * 8) = (u32x4){0u, 0u, 0u, 0u};
      }
    }
    for (int i = blockIdx.x * 256 + threadIdx.x; i < 8208 * 16; i += G * 256) {
      const int pos = i >> 4, k = i & 15;
      const float ang = (float)pos * p.inv_freq[k];
      const double ad = (double)ang;
      const double q = rint(ad * 0.15915494309189535);
      const float rr = (float)(ad - q * 6.283185307179586);
      tab[i] = make_float2(__cosf(rr), __sinf(rr));
    }
    postnorm_phase(p, nullptr, 0, 0.f, nullptr, p.norm_gains, 0, false, Ab, false);
  }
  xcd_barrier(xb);
  if (p.ws == nullptr) grid.sync();

  for (int li = 0; li < 2; ++li) {
    const float* gains = p.norm_gains + (size_t)li * 6 * DM;
    {
      GemmJob J{}; J.A = Ab; J.lda = DM; J.Bt = Wb + (size_t)(li * 2) * W_FFN_EL; J.K = DM; J.NR = 5632; J.ablk = 1; J.nt0 = 0; J.ntn = 22; J.C = Hb; J.ldc = DFF;
      gemm_run<0, 8>(J, smem, 0);
    }
    xcd_barrier(xb);
    {
      GemmJob J{}; J.A = Hb; J.lda = DFF; J.Bt = Wb + (size_t)(li * 2) * W_FFN_EL + W_GU_EL; J.K = DFF; J.NR = 1024; J.ablk = 1; J.cblk = 1; J.rev = 1; J.nt0 = 0; J.ntn = 4; J.C = Ab; J.ldc = DM; J.nvalid = DM;
      gemm_run<1, 8>(J, smem, 0);
    }
    xcd_barrier(xb);
    postnorm_phase(p, Ab, DM, 0.5f, gains + DM, gains + 2 * DM, li == 0 ? 0 : 1, true, Ab, true);
    xcd_barrier(xb);
    if (li == 0) {
      {
        GemmJob J{}; J.A = Ab; J.lda = DM; J.Bt = Wb + W_IN_OFF; J.K = DM; J.NR = 1536; J.ablk = 1; J.nt0 = 0; J.ntn = 5; J.C = Hb + H_PROJ; J.ldc = 1056; J.nvalid = 1056;
        gemm_run<1, 8>(J, smem, 0);
        GemmJob V{}; V.A = Ab; V.lda = DM; V.Bt = Wb + W_IN_OFF; V.K = DM; V.NR = 1536; V.ablk = 1; V.nt0 = 5; V.ntn = 1; V.C = Hb + H_VTG; V.nfirst = 1280; V.vrows = 128;
        gemm_run<2, 8>(V, smem, (MT128 * 5) % G);
      }
      xcd_barrier(xb);
      split_phase(p);
      xcd_barrier(xb);
      {
        GemmJob J{}; J.A = Hb + H_PROJ; J.lda = 1056; J.Bt = Wb + W_UQ_OFF; J.K = 256; J.NR = 768; J.nt0 = 0; J.ntn = 3; J.C = Hb + H_QA; J.ldc = 768; J.nvalid = 768; J.tab = tab;
        gemm_run<3, 8>(J, smem, 0);
        GemmJob Kj{}; Kj.A = Hb + H_PROJ + 256; Kj.lda = 1056; Kj.Bt = Wb + W_UKV_OFF; Kj.K = 128; Kj.NR = 1024; Kj.nt0 = 0; Kj.ntn = 2; Kj.C = Hb + H_KMLA; Kj.ldc = 768; Kj.nvalid = 512;
        gemm_run<4, 8>(Kj, smem, (MT128 * 3) % G);
        GemmJob V{}; V.A = Hb + H_PROJ + 256; V.lda = 1056; V.Bt = Wb + W_UKV_OFF; V.K = 128; V.NR = 1024; V.nt0 = 2; V.ntn = 2; V.C = Hb + H_VTM; V.nfirst = 512; V.vrows = 512;
        gemm_run<2, 8>(V, smem, (MT128 * 5) % G);
      }
      xcd_barrier(xb);
      attn_dense_phase(p, smem, ctr + 0);
      xcd_barrier(xb);
      {
        GemmJob J{}; J.A = Ab; J.lda = DM; J.Bt = Wb + W_OUT_OFF; J.K = DM; J.NR = 1024; J.ablk = 1; J.nt0 = 0; J.ntn = 4; J.C = Hb; J.ldc = DM; J.nvalid = DM;
        gemm_run<1, 8>(J, smem, 0);
      }
      xcd_barrier(xb);
    } else {
      {
        GemmJob J{}; J.A = Ab; J.lda = DM; J.Bt = Wb + W_NAQKV_OFF; J.K = DM; J.NR = 3072; J.ablk = 1; J.nt0 = 0; J.ntn = 8; J.C = Hb + H_NAQK; J.ldc = 2048; J.nvalid = 2048;
        gemm_run<1, 8>(J, smem, 0);
        GemmJob V{}; V.A = Ab; V.lda = DM; V.Bt = Wb + W_NAQKV_OFF; V.K = DM; V.NR = 3072; V.ablk = 1; V.nt0 = 8; V.ntn = 4; V.C = Hb + H_VTN; V.nfirst = 2048; V.vrows = 1024;
        gemm_run<2, 8>(V, smem, (MT128 * 8) % G);
      }
      xcd_barrier(xb);
      attn_na_phase(p, smem, ctr + 1);
      xcd_barrier(xb);
      {
        GemmJob J{}; J.A = Ab; J.lda = DM; J.Bt = Wb + W_NAOUT_OFF; J.K = DM; J.NR = 1024; J.ablk = 1; J.nt0 = 0; J.ntn = 4; J.C = Hb; J.ldc = DM; J.nvalid = DM;
        gemm_run<1, 8>(J, smem, 0);
      }
      xcd_barrier(xb);
    }
    postnorm_phase(p, Hb, DM, 1.0f, gains + 3 * DM, gains + 4 * DM, 1, true, Ab, false);
    xcd_barrier(xb);
    {
      GemmJob J{}; J.A = Ab; J.lda = DM; J.Bt = Wb + (size_t)(li * 2 + 1) * W_FFN_EL; J.K = DM; J.NR = 5632; J.ablk = 1; J.nt0 = 0; J.ntn = 22; J.C = Hb; J.ldc = DFF;
      gemm_run<0, 8>(J, smem, 0);
    }
    xcd_barrier(xb);
    {
      GemmJob J{}; J.A = Hb; J.lda = DFF; J.Bt = Wb + (size_t)(li * 2 + 1) * W_FFN_EL + W_GU_EL; J.K = DFF; J.NR = 1024; J.ablk = 1; J.cblk = 1; J.rev = 1; J.nt0 = 0; J.ntn = 4; J.C = Ab; J.ldc = DM; J.nvalid = DM;
      gemm_run<1, 8>(J, smem, 0);
    }
    xcd_barrier(xb);
    if (li == 0) postnorm_phase(p, Ab, DM, 0.5f, gains + 5 * DM, gains + 6 * DM, 1, true, Ab, true);
    else         postnorm_phase(p, Ab, DM, 0.5f, gains + 5 * DM, nullptr, 1, true, nullptr, true);
    if (li == 0) xcd_barrier(xb);
  }
}

extern "C" void kernel_launch(void* const* d_in, const int* in_sizes, int n_in, void* d_out, int out_size,
                              void* d_ws, size_t ws_size, hipStream_t stream) {
  (void)in_sizes; (void)n_in; (void)out_size;
  if (ws_size < WS_NEED) { fprintf(stderr, "workspace too small: %zu < %zu\n", ws_size, (size_t)WS_NEED); return; }
  static int grid_blocks = 0;
  if (!grid_blocks) {
    int dev = 0, cus = 0, per_cu = 0;
    hipGetDevice(&dev);
    hipDeviceGetAttribute(&cus, hipDeviceAttributeMultiprocessorCount, dev);
    hipOccupancyMaxActiveBlocksPerMultiprocessor(&per_cu, fwd_megakernel, 256, 0);
    per_cu = 2;
    grid_blocks = cus * per_cu;
  }
  Params p{};
  p.x_prompt = (const float*)d_in[0]; p.x_sample = (const float*)d_in[1]; p.meta = (const float*)d_in[2]; p.norm_gains = (const float*)d_in[3];
  for (int i = 0; i < 6; ++i) p.ffn_w[i] = (const float*)d_in[4 + i];
  p.attn_w_in = (const float*)d_in[10]; p.mla_q_norm = (const float*)d_in[11]; p.mla_w_uq = (const float*)d_in[12];
  p.mla_kv_norm = (const float*)d_in[13]; p.mla_w_ukv = (const float*)d_in[14]; p.gqa_q_norm = (const float*)d_in[15];
  p.gqa_k_norm = (const float*)d_in[16]; p.attn_w_out = (const float*)d_in[17]; p.na_w_qkv = (const float*)d_in[18];
  p.na_rpb = (const float*)d_in[19]; p.na_meta_bias = (const float*)d_in[20]; p.na_w_out = (const float*)d_in[21];
  p.out = (float*)d_out; p.ws = (unsigned char*)d_ws;
  for (int i = 0; i < 16; ++i) p.inv_freq[i] = (float)(1.0 / pow(10000.0, (double)i / 16.0));
  (void)hipMemsetAsync(d_ws, 0, WS_TAB, stream);
  void* args[] = {&p};
  hipError_t e = hipLaunchCooperativeKernel((void*)fwd_megakernel, dim3(grid_blocks), dim3(256), args, 0, stream);
  if (e != hipSuccess) fprintf(stderr, "cooperative launch failed: %s (grid %d)\n", hipGetErrorString(e), grid_blocks);
}
```
